# Optimizing an MI355X kernel written in HIP

```python
import math
import jax, jax.numpy as jnp
from jax import lax
import numpy as np

D_MODEL = 2048
BATCH = 4
SEQ = 2048
DEPTH = 1

CHUNK = 64
Q_BLOCK = 128
MIX_WIDTH = D_MODEL
ATTN_WIDTH = MIX_WIDTH // 2
RET_WIDTH = MIX_WIDTH - ATTN_WIDTH
ATTN_HEADS = 8
HEAD_DIM = ATTN_WIDTH // ATTN_HEADS
KV_HEADS = 2
KV_WIDTH = KV_HEADS * HEAD_DIM
IDX_HEADS = 16
IDX_DIM = 64
TOPK_MAX = 256
RET_HEADS = 8
RET_DK = RET_WIDTH // RET_HEADS
RET_DV = RET_WIDTH // RET_HEADS
ROT_BASE = 10000.0
N_GROUPS = 4
EXPERTS_PER_GROUP = 8
N_EXPERTS = N_GROUPS * EXPERTS_PER_GROUP
TOP_EXPERTS = 2
EXPERT_FF = D_MODEL // 4
EPS = 1e-6

IN_SPLITS = (ATTN_WIDTH, KV_WIDTH, KV_WIDTH,
             IDX_HEADS * IDX_DIM, IDX_DIM, IDX_HEADS,
             RET_WIDTH, RET_WIDTH, RET_WIDTH, RET_WIDTH)
IN_WIDTH = sum(IN_SPLITS)

kernel_name = "hybrid_dsa_retention_hmoe"


def rms_norm(x, g):
    xf = x.astype(jnp.float32)
    y = xf * lax.rsqrt(jnp.mean(xf * xf, axis=-1, keepdims=True) + EPS)
    return (y * g.astype(jnp.float32)).astype(x.dtype)


def layer_norm(x, w, b):
    xf = x.astype(jnp.float32)
    mu = jnp.mean(xf, axis=-1, keepdims=True)
    var = jnp.mean(jnp.square(xf - mu), axis=-1, keepdims=True)
    y = (xf - mu) * lax.rsqrt(var + EPS)
    return (y * w.astype(jnp.float32) + b.astype(jnp.float32)).astype(x.dtype)


def split_columns(a, sizes):
    out, start = [], 0
    for s in sizes:
        out.append(a[..., start:start + s])
        start += s
    return out


def rotate(x, pos):
    half = x.shape[-1] // 2
    inv = 1.0 / (ROT_BASE ** jnp.linspace(0.0, 1.0, half, dtype=jnp.float32))
    ang = pos[:, None] * inv[None, :]
    c = jnp.cos(ang)[None, :, None, :]
    s = jnp.sin(ang)[None, :, None, :]
    x1, x2 = x[..., :half], x[..., half:]
    return jnp.concatenate([x1 * c - x2 * s, x1 * s + x2 * c], axis=-1)


def dsa_attention(q, k, v, qi, ki, wi):
    B, S = q.shape[0], q.shape[1]
    topk = min(TOPK_MAX, S // 4)
    nb = S // Q_BLOCK
    key_chunk = jnp.arange(S) // CHUNK
    ki32 = ki.astype(jnp.float32)

    def to_blocks(a):
        return a.reshape((B, nb, Q_BLOCK) + a.shape[2:]).swapaxes(0, 1)

    def block(args):
        qb, qib, wib, start = args
        q_chunk = (start + jnp.arange(Q_BLOCK)) // CHUNK
        visible = key_chunk[None, :] <= q_chunk[:, None]
        dots = jnp.einsum('bthd,bsd->bths', qib.astype(jnp.float32), ki32)
        score = jnp.einsum('bths,bth->bts', jax.nn.relu(dots), wib.astype(jnp.float32))
        score = jnp.where(visible[None], score, -jnp.inf)
        _, idx = lax.top_k(score, topk)
        valid = key_chunk[idx] <= q_chunk[None, :, None]
        ks = jax.vmap(lambda kb, ib: kb[ib])(k, idx)
        vs = jax.vmap(lambda vb, ib: vb[ib])(v, idx)
        qg = qb.reshape(B, Q_BLOCK, KV_HEADS, ATTN_HEADS // KV_HEADS, HEAD_DIM)
        s = jnp.einsum('btgrd,btkgd->btgrk', qg, ks).astype(jnp.float32) * (HEAD_DIM ** -0.5)
        s = jnp.where(valid[:, :, None, None, :], s, -jnp.inf)
        p = jax.nn.softmax(s, axis=-1).astype(v.dtype)
        o = jnp.einsum('btgrk,btkgd->btgrd', p, vs)
        return o.reshape(B, Q_BLOCK, ATTN_WIDTH)

    starts = jnp.arange(nb) * Q_BLOCK
    out = lax.map(block, (to_blocks(q), to_blocks(qi), to_blocks(wi), starts))
    return out.swapaxes(0, 1).reshape(B, S, ATTN_WIDTH)


def retention(q, k, v):
    B, S, H, dk = q.shape
    dv = v.shape[-1]
    nc = S // CHUNK
    log_gamma = jnp.log1p(-jnp.exp2(-5.0 - jnp.arange(H, dtype=jnp.float32)))
    n = jnp.arange(CHUNK, dtype=jnp.float32)
    rel = n[:, None] - n[None, :]
    intra = jnp.where(rel >= 0, jnp.exp(log_gamma[:, None, None] * jnp.maximum(rel, 0.0)), 0.0)
    cross_decay = jnp.exp(log_gamma[:, None] * (n + 1.0))[..., None]
    state_decay = jnp.exp(log_gamma[:, None] * (CHUNK - 1.0 - n))[..., None]
    chunk_decay = jnp.exp(log_gamma * CHUNK)[:, None, None]

    def to_chunks(a):
        return a.reshape(B, nc, CHUNK, H, a.shape[-1]).transpose(1, 0, 3, 2, 4)

    def step(R, inp):
        qc, kc, vc = inp
        inner = jnp.einsum('bhnd,bhmd->bhnm', qc, kc) * intra
        o = jnp.einsum('bhnm,bhme->bhne', inner, vc) + jnp.einsum('bhnd,bhde->bhne', qc, R) * cross_decay
        R = R * chunk_decay + jnp.einsum('bhmd,bhme->bhde', kc * state_decay, vc)
        return R, o

    R0 = jnp.zeros((B, H, dk, dv), jnp.float32)
    _, o = lax.scan(step, R0, (to_chunks(q), to_chunks(k), to_chunks(v)))
    return o.transpose(1, 0, 3, 2, 4).reshape(B, S, H, dv)


def hier_moe(h, w_group, w_router, w1, w3, w2):
    B, S, D = h.shape
    hf = h.reshape(B * S, D)
    h32 = hf.astype(jnp.float32)
    g_logits = h32 @ w_group.astype(jnp.float32)
    g_prob = jax.nn.softmax(g_logits, axis=-1)
    g_sel = jnp.argmax(g_logits, axis=-1)
    g_gate = jnp.take_along_axis(g_prob, g_sel[:, None], axis=-1)
    e_logits = jnp.einsum('nd,gde->nge', h32, w_router.astype(jnp.float32))
    e_logits = jnp.take_along_axis(e_logits, g_sel[:, None, None], axis=1)[:, 0]
    top_v, top_i = lax.top_k(e_logits, TOP_EXPERTS)
    top_w = jax.nn.softmax(top_v, axis=-1) * g_gate
    expert_id = g_sel[:, None] * EXPERTS_PER_GROUP + top_i
    comb = jnp.sum(jax.nn.one_hot(expert_id, N_EXPERTS, dtype=jnp.float32) * top_w[..., None], axis=1)
    a = jnp.einsum('nd,edf->nef', hf, w1)
    b = jnp.einsum('nd,edf->nef', hf, w3)
    y = jnp.einsum('nef,efd->nd', jax.nn.silu(a) * b * comb[..., None].astype(h.dtype), w2)
    return y.reshape(B, S, D)


def setup_inputs(seed: int = 0) -> dict:
    key = jax.random.key(seed)
    ks = jax.random.split(key, 16)
    f32 = jnp.float32

    def nrm(k, shape, fan_in):
        return jax.random.normal(k, shape, f32) * (fan_in ** -0.5)

    def gain(k, shape):
        return 1.0 + 0.01 * jax.random.normal(k, shape, f32)

    return {
        "x": jax.random.normal(ks[0], (BATCH, SEQ, D_MODEL), f32),
        "norm1_g": gain(ks[1], (DEPTH, D_MODEL)),
        "w_in": nrm(ks[2], (DEPTH, D_MODEL, IN_WIDTH), D_MODEL),
        "q_norm_g": gain(ks[3], (DEPTH, HEAD_DIM)),
        "k_norm_g": gain(ks[4], (DEPTH, HEAD_DIM)),
        "idx_k_ln_w": gain(ks[5], (DEPTH, IDX_DIM)),
        "idx_k_ln_b": 0.01 * jax.random.normal(ks[6], (DEPTH, IDX_DIM), f32),
        "ret_norm_g": gain(ks[7], (DEPTH, RET_WIDTH)),
        "w_out": nrm(ks[8], (DEPTH, MIX_WIDTH, D_MODEL), MIX_WIDTH),
        "norm2_g": gain(ks[9], (DEPTH, D_MODEL)),
        "w_group": nrm(ks[10], (DEPTH, D_MODEL, N_GROUPS), D_MODEL),
        "w_router": nrm(ks[11], (DEPTH, N_GROUPS, D_MODEL, EXPERTS_PER_GROUP), D_MODEL),
        "w1": nrm(ks[12], (DEPTH, N_EXPERTS, D_MODEL, EXPERT_FF), D_MODEL),
        "w3": nrm(ks[13], (DEPTH, N_EXPERTS, D_MODEL, EXPERT_FF), D_MODEL),
        "w2": nrm(ks[14], (DEPTH, N_EXPERTS, EXPERT_FF, D_MODEL), EXPERT_FF),
    }


def reference(x, norm1_g, w_in, q_norm_g, k_norm_g, idx_k_ln_w, idx_k_ln_b, ret_norm_g,
              w_out, norm2_g, w_group, w_router, w1, w3, w2):
    B, S, _ = x.shape
    pos = jnp.arange(S, dtype=jnp.float32)
    idx_w_scale = (IDX_HEADS ** -0.5) * (IDX_DIM ** -0.5)
    for l in range(DEPTH):
        h = rms_norm(x, norm1_g[l])
        proj = h @ w_in[l]
        aq, ak, av, iq, ik, iw, rq, rk, rv, rg = split_columns(proj, IN_SPLITS)

        aq = rms_norm(aq.reshape(B, S, ATTN_HEADS, HEAD_DIM), q_norm_g[l])
        ak = rms_norm(ak.reshape(B, S, KV_HEADS, HEAD_DIM), k_norm_g[l])
        av = av.reshape(B, S, KV_HEADS, HEAD_DIM)
        iq = iq.reshape(B, S, IDX_HEADS, IDX_DIM)
        ik = layer_norm(ik, idx_k_ln_w[l], idx_k_ln_b[l])
        iw = iw * idx_w_scale
        attn_out = dsa_attention(aq, ak, av, iq, ik, iw)

        rq = rotate(rq.reshape(B, S, RET_HEADS, RET_DK).astype(jnp.float32), pos)
        rk = rotate(rk.reshape(B, S, RET_HEADS, RET_DK).astype(jnp.float32), pos) * (RET_DK ** -0.5)
        rv = rv.reshape(B, S, RET_HEADS, RET_DV).astype(jnp.float32)
        ret = retention(rq, rk, rv)
        ret = rms_norm(ret, ret_norm_g[l].reshape(RET_HEADS, RET_DV)).reshape(B, S, RET_WIDTH)
        ret_out = (jax.nn.silu(rg.astype(jnp.float32)) * ret).astype(x.dtype)

        mixed = jnp.concatenate([attn_out.astype(x.dtype), ret_out], axis=-1) @ w_out[l]
        x = x + mixed

        x = x + hier_moe(rms_norm(x, norm2_g[l]), w_group[l], w_router[l], w1[l], w3[l], w2[l])
    return x
```

```cpp
#include <hip/hip_runtime.h>
#include <cstdint>
#include <cstdio>

namespace cfg {
constexpr int B = 4, S = 2048, D = 2048, NT = B * S;
constexpr int INW = 6736;
constexpr int OQ = 0, OKK = 1024, OV = 1280, OIQ = 1536, OIK = 2560, OIW = 2624, ORQ = 2640, ORK = 3664, ORV = 4688, ORG = 5712;
constexpr int NE = 32, FF = 512;
constexpr float EPS = 1e-6f;
constexpr int MAXROWS = 16384 + 32 * 64;
constexpr int MAXTILES = MAXROWS / 64;
}
using namespace cfg;

constexpr size_t MiB = 1u << 20;
constexpr size_t WS_CTL = 0;
constexpr size_t WS_THR = 64 * 1024;
constexpr size_t WS_EID = 128 * 1024;
constexpr size_t WS_EW = 192 * 1024;
constexpr size_t WS_SLOT = 256 * 1024;
constexpr size_t WS_SLOTW = 320 * 1024;
constexpr size_t WS_ROT = 1 * MiB;
constexpr size_t WS_H = 2 * MiB;
constexpr size_t WS_PROJ = 66 * MiB;
constexpr size_t WS_I = 280 * MiB;
constexpr size_t WS_CAT = 344 * MiB;
constexpr size_t WS_XG = 66 * MiB;
constexpr size_t WS_A1 = 210 * MiB;
constexpr size_t WS_B3 = 246 * MiB;
constexpr size_t WS_END = 408 * MiB;

__device__ __forceinline__ float wave_sum(float v) {
#pragma unroll
    for (int o = 1; o < 64; o <<= 1) v += __shfl_xor(v, o);
    return v;
}
__device__ __forceinline__ float wave_max(float v) {
#pragma unroll
    for (int o = 1; o < 64; o <<= 1) v = fmaxf(v, __shfl_xor(v, o));
    return v;
}
__device__ __forceinline__ float block_sum(float v, float* red) {
    v = wave_sum(v);
    __syncthreads();
    if ((threadIdx.x & 63) == 0) red[threadIdx.x >> 6] = v;
    __syncthreads();
    return red[0] + red[1] + red[2] + red[3];
}
__device__ __forceinline__ float block_max(float v, float* red) {
    v = wave_max(v);
    __syncthreads();
    if ((threadIdx.x & 63) == 0) red[threadIdx.x >> 6] = v;
    __syncthreads();
    return fmaxf(fmaxf(red[0], red[1]), fmaxf(red[2], red[3]));
}
__device__ __forceinline__ unsigned fkey(float f) {
    unsigned u = __float_as_uint(f);
    return (u & 0x80000000u) ? ~u : (u | 0x80000000u);
}

__global__ void __launch_bounds__(256) k_rot_table(float2* tab) {
    int idx = blockIdx.x * 256 + threadIdx.x;
    if (idx >= 2048 * 64) return;
    int pos = idx >> 6, i = idx & 63;
    double inv = exp(-log(10000.0) * (double)i / 63.0);
    double ang = (double)pos * inv;
    tab[idx] = make_float2((float)cos(ang), (float)sin(ang));
}

__global__ void __launch_bounds__(256) k_rmsnorm(const float* x, const float* g, float* out) {
    __shared__ float red[8];
    const int t = blockIdx.x;
    const float* xr = x + (size_t)t * D;
    float v[8], ss = 0.f;
#pragma unroll
    for (int j = 0; j < 8; ++j) { v[j] = xr[threadIdx.x + 256 * j]; ss += v[j] * v[j]; }
    ss = block_sum(ss, red);
    const float r = rsqrtf(ss * (1.0f / D) + EPS);
#pragma unroll
    for (int j = 0; j < 8; ++j) out[(size_t)t * D + threadIdx.x + 256 * j] = v[j] * r * g[threadIdx.x + 256 * j];
}

__global__ void __launch_bounds__(256) k_gemm_f32(const float* A, int lda, const float* Bm, int ldb, float* C, int ldc,
                                                  int N, int K, const float* R, int ldr, const int* tile_e, size_t strideB) {
    __shared__ float As[16][65];
    __shared__ float Bs[16][64];
    if (tile_e) { int e = tile_e[blockIdx.y]; if (e < 0) return; Bm += (size_t)e * strideB; }
    const int tx = threadIdx.x & 15, ty = threadIdx.x >> 4;
    const int m0 = blockIdx.y * 64, n0 = blockIdx.x * 64;
    float acc[4][4];
#pragma unroll
    for (int i = 0; i < 4; ++i)
#pragma unroll
        for (int j = 0; j < 4; ++j) acc[i][j] = 0.f;
    for (int k0 = 0; k0 < K; k0 += 16) {
#pragma unroll
        for (int q = 0; q < 4; ++q) { int i = threadIdx.x + 256 * q; int r = i >> 4, c = i & 15; As[c][r] = A[(size_t)(m0 + r) * lda + k0 + c]; }
#pragma unroll
        for (int q = 0; q < 4; ++q) { int i = threadIdx.x + 256 * q; int r = i >> 6, c = i & 63; int n = n0 + c; Bs[r][c] = (n < N) ? Bm[(size_t)(k0 + r) * ldb + n] : 0.f; }
        __syncthreads();
#pragma unroll
        for (int kk = 0; kk < 16; ++kk) {
            float a[4], b[4];
#pragma unroll
            for (int i = 0; i < 4; ++i) a[i] = As[kk][ty * 4 + i];
#pragma unroll
            for (int j = 0; j < 4; ++j) b[j] = Bs[kk][tx * 4 + j];
#pragma unroll
            for (int i = 0; i < 4; ++i)
#pragma unroll
                for (int j = 0; j < 4; ++j) acc[i][j] += a[i] * b[j];
        }
        __syncthreads();
    }
#pragma unroll
    for (int i = 0; i < 4; ++i)
#pragma unroll
        for (int j = 0; j < 4; ++j) {
            int m = m0 + ty * 4 + i, n = n0 + tx * 4 + j;
            if (n < N) { float v = acc[i][j]; if (R) v += R[(size_t)m * ldr + n]; C[(size_t)m * ldc + n] = v; }
        }
}

__global__ void __launch_bounds__(256) k_postproj(float* proj, const float* qg, const float* kg, const float* lnw, const float* lnb, const float2* rot) {
    const int t = blockIdx.x, tl = t & (S - 1);
    float* p = proj + (size_t)t * INW;
    const int w = threadIdx.x >> 6, lane = threadIdx.x & 63;
    for (int h = w; h < 8; h += 4) {
        float* q = p + OQ + h * 128; float a = q[lane], b = q[lane + 64];
        float ss = wave_sum(a * a + b * b); float r = rsqrtf(ss * (1.0f / 128) + EPS);
        q[lane] = a * r * qg[lane]; q[lane + 64] = b * r * qg[lane + 64];
    }
    if (w < 2) {
        float* q = p + OKK + w * 128; float a = q[lane], b = q[lane + 64];
        float ss = wave_sum(a * a + b * b); float r = rsqrtf(ss * (1.0f / 128) + EPS);
        q[lane] = a * r * kg[lane]; q[lane + 64] = b * r * kg[lane + 64];
    }
    if (w == 2) {
        float v = p[OIK + lane]; float mean = wave_sum(v) * (1.0f / 64); float d = v - mean;
        float var = wave_sum(d * d) * (1.0f / 64);
        p[OIK + lane] = d * rsqrtf(var + EPS) * lnw[lane] + lnb[lane];
    }
    if (w == 3 && lane < 16) p[OIW + lane] *= 0.03125f;
    for (int it = w; it < 16; it += 4) {
        const int which = it >> 3, h = it & 7;
        float* r = p + (which ? ORK : ORQ) + h * 128;
        const float2 cs = rot[tl * 64 + lane];
        const float x1 = r[lane], x2 = r[lane + 64];
        const float sc = which ? 0.08838834764831845f : 1.f;
        r[lane] = (x1 * cs.x - x2 * cs.y) * sc; r[lane + 64] = (x1 * cs.y + x2 * cs.x) * sc;
    }
}

__global__ void __launch_bounds__(256) k_index(const float* proj, float* I) {
    __shared__ float siq[1024];
    __shared__ float siw[16];
    const int t = blockIdx.x, tl = t & (S - 1), b0 = t - tl;
    const float* p = proj + (size_t)t * INW;
    for (int i = threadIdx.x; i < 1024; i += 256) siq[i] = p[OIQ + i];
    if (threadIdx.x < 16) siw[threadIdx.x] = p[OIW + threadIdx.x];
    __syncthreads();
    const int nvis = 64 * (tl / 64 + 1);
    for (int s = threadIdx.x; s < S; s += 256) {
        float out = -INFINITY;
        if (s < nvis) {
            const float* kp = proj + (size_t)(b0 + s) * INW + OIK;
            float kk[64];
#pragma unroll
            for (int d = 0; d < 64; ++d) kk[d] = kp[d];
            float acc = 0.f;
            for (int h = 0; h < 16; ++h) {
                float dot = 0.f;
#pragma unroll
                for (int d = 0; d < 64; ++d) dot += siq[h * 64 + d] * kk[d];
                acc += siw[h] * fmaxf(dot, 0.f);
            }
            out = acc;
        }
        I[(size_t)t * S + s] = out;
    }
}

__global__ void __launch_bounds__(256) k_thresh(const float* I, unsigned* thr) {
    __shared__ float red[8];
    const int t = blockIdx.x;
    unsigned key[8];
#pragma unroll
    for (int j = 0; j < 8; ++j) key[j] = fkey(I[(size_t)t * S + threadIdx.x + 256 * j]);
    unsigned T = 0;
    for (int bit = 31; bit >= 0; --bit) {
        const unsigned cand = T | (1u << bit);
        float c = 0.f;
#pragma unroll
        for (int j = 0; j < 8; ++j) c += (key[j] >= cand) ? 1.f : 0.f;
        c = block_sum(c, red);
        if (c >= 256.f) T = cand;
    }
    if (threadIdx.x == 0) thr[t] = T;
}

__global__ void __launch_bounds__(256) k_attn(const float* proj, const float* I, const unsigned* thr, float* cat) {
    __shared__ float sq[4 * 128];
    __shared__ float sc[4][2048];
    __shared__ float red[8];
    __shared__ float comb[256];
    const int t = blockIdx.x, tl = t & (S - 1), b0 = t - tl;
    const int nvis = 64 * (tl / 64 + 1);
    const unsigned T = thr[t];
    const float* p = proj + (size_t)t * INW;
    for (int g = 0; g < 2; ++g) {
        __syncthreads();
        for (int i = threadIdx.x; i < 512; i += 256) sq[i] = p[OQ + g * 512 + i];
        __syncthreads();
        for (int s = threadIdx.x; s < nvis; s += 256) {
            const bool sel = fkey(I[(size_t)t * S + s]) >= T;
            float d0 = -INFINITY, d1 = -INFINITY, d2 = -INFINITY, d3 = -INFINITY;
            if (sel) {
                const float* kp = proj + (size_t)(b0 + s) * INW + OKK + g * 128;
                d0 = d1 = d2 = d3 = 0.f;
                for (int d = 0; d < 128; ++d) { const float kv = kp[d]; d0 += sq[d] * kv; d1 += sq[128 + d] * kv; d2 += sq[256 + d] * kv; d3 += sq[384 + d] * kv; }
                const float scl = 0.08838834764831845f;
                d0 *= scl; d1 *= scl; d2 *= scl; d3 *= scl;
            }
            sc[0][s] = d0; sc[1][s] = d1; sc[2][s] = d2; sc[3][s] = d3;
        }
        __syncthreads();
        float inv[4];
        for (int hh = 0; hh < 4; ++hh) {
            float m = -INFINITY;
            for (int s = threadIdx.x; s < nvis; s += 256) m = fmaxf(m, sc[hh][s]);
            m = block_max(m, red);
            float sum = 0.f;
            for (int s = threadIdx.x; s < nvis; s += 256) { const float v = sc[hh][s]; const float e = (v == -INFINITY) ? 0.f : expf(v - m); sc[hh][s] = e; sum += e; }
            sum = block_sum(sum, red);
            inv[hh] = 1.0f / sum;
        }
        __syncthreads();
        const int d = threadIdx.x & 127, half = threadIdx.x >> 7;
        for (int rep = 0; rep < 2; ++rep) {
            const int hh = half + 2 * rep;
            float acc = 0.f;
            for (int s = 0; s < nvis; ++s) {
                const float pe = sc[hh][s];
                if (pe != 0.f) acc += pe * proj[(size_t)(b0 + s) * INW + OV + g * 128 + d];
            }
            cat[(size_t)t * D + (g * 4 + hh) * 128 + d] = acc * inv[hh];
        }
    }
}

__global__ void __launch_bounds__(256) k_ret(const float* proj, const float* rng, float* cat) {
    __shared__ float sq[128];
    __shared__ float sw[2048];
    __shared__ float comb[256];
    __shared__ float red[8];
    const int t = blockIdx.x, tl = t & (S - 1), b0 = t - tl;
    const float* p = proj + (size_t)t * INW;
    for (int h = 0; h < 8; ++h) {
        __syncthreads();
        if (threadIdx.x < 128) sq[threadIdx.x] = p[ORQ + h * 128 + threadIdx.x];
        __syncthreads();
        const float lg = log1pf(-exp2f(-5.0f - (float)h));
        for (int m = threadIdx.x; m <= tl; m += 256) {
            const float* kp = proj + (size_t)(b0 + m) * INW + ORK + h * 128;
            float dot = 0.f;
            for (int d = 0; d < 128; ++d) dot += sq[d] * kp[d];
            sw[m] = dot * expf(lg * (float)(tl - m));
        }
        __syncthreads();
        const int e = threadIdx.x & 127, half = threadIdx.x >> 7;
        float acc = 0.f;
        for (int m = half; m <= tl; m += 2) acc += sw[m] * proj[(size_t)(b0 + m) * INW + ORV + h * 128 + e];
        comb[threadIdx.x] = acc;
        __syncthreads();
        float o = comb[e] + comb[e + 128];
        float ss = block_sum(half == 0 ? o * o : 0.f, red);
        if (half == 0) {
            const float y = o * rsqrtf(ss * (1.0f / 128) + EPS) * rng[h * 128 + e];
            const float gt = p[ORG + h * 128 + e];
            cat[(size_t)t * D + 1024 + h * 128 + e] = gt / (1.0f + expf(-gt)) * y;
        }
    }
}

__global__ void __launch_bounds__(256) k_router(const float* x1, const float* g2, const float* wg, const float* wr, float* h2, int* eid, float* ew, int* cnt) {
    __shared__ float red[8];
    __shared__ float lg[36];
    const int t = blockIdx.x;
    float v[8], ss = 0.f;
#pragma unroll
    for (int j = 0; j < 8; ++j) { v[j] = x1[(size_t)t * D + threadIdx.x + 256 * j]; ss += v[j] * v[j]; }
    ss = block_sum(ss, red);
    const float r = rsqrtf(ss * (1.0f / D) + EPS);
#pragma unroll
    for (int j = 0; j < 8; ++j) { v[j] = v[j] * r * g2[threadIdx.x + 256 * j]; h2[(size_t)t * D + threadIdx.x + 256 * j] = v[j]; }
    for (int c = 0; c < 36; ++c) {
        float pa = 0.f;
#pragma unroll
        for (int j = 0; j < 8; ++j) {
            const int d = threadIdx.x + 256 * j;
            const float w = (c < 4) ? wg[d * 4 + c] : wr[((size_t)((c - 4) >> 3) * D + d) * 8 + ((c - 4) & 7)];
            pa += v[j] * w;
        }
        pa = block_sum(pa, red);
        if (threadIdx.x == 0) lg[c] = pa;
    }
    __syncthreads();
    if (threadIdx.x == 0) {
        int gs = 0; for (int c = 1; c < 4; ++c) if (lg[c] > lg[gs]) gs = c;
        float den = 0.f; for (int c = 0; c < 4; ++c) den += expf(lg[c] - lg[gs]);
        const float gate = 1.0f / den;
        const float* el = lg + 4 + gs * 8;
        int i0 = 0; for (int c = 1; c < 8; ++c) if (el[c] > el[i0]) i0 = c;
        int i1 = -1; for (int c = 0; c < 8; ++c) if (c != i0 && (i1 < 0 || el[c] > el[i1])) i1 = c;
        const float e1 = expf(el[i1] - el[i0]);
        const float w0 = 1.0f / (1.0f + e1) * gate, w1 = e1 / (1.0f + e1) * gate;
        eid[t * 2] = gs * 8 + i0; eid[t * 2 + 1] = gs * 8 + i1; ew[t * 2] = w0; ew[t * 2 + 1] = w1;
        atomicAdd(&cnt[gs * 8 + i0], 1); atomicAdd(&cnt[gs * 8 + i1], 1);
    }
}

__global__ void k_offsets(const int* cnt, int* off, int* tile_e) {
    if (threadIdx.x == 0) {
        int o = 0;
        for (int e = 0; e < NE; ++e) { off[e] = o; const int nt = (cnt[e] + 63) / 64; for (int i = 0; i < nt; ++i) tile_e[o / 64 + i] = e; o += nt * 64; }
        off[NE] = o;
        for (int i = o / 64; i < MAXTILES; ++i) tile_e[i] = -1;
    }
}

__global__ void __launch_bounds__(256) k_fill(const float* h2, const int* eid, const float* ew, const int* off, int* fill, int* slot_of, float* slotw, float* xg) {
    __shared__ int sslot[2];
    const int t = blockIdx.x;
    if (threadIdx.x < 2) {
        const int e = eid[t * 2 + threadIdx.x];
        const int slot = off[e] + atomicAdd(&fill[e], 1);
        sslot[threadIdx.x] = slot; slot_of[t * 2 + threadIdx.x] = slot; slotw[slot] = ew[t * 2 + threadIdx.x];
    }
    __syncthreads();
    for (int k = 0; k < 2; ++k)
        for (int d = threadIdx.x; d < D; d += 256) xg[(size_t)sslot[k] * D + d] = h2[(size_t)t * D + d];
}
__global__ void __launch_bounds__(256) k_padzero(const int* cnt, const int* off, float* slotw, float* xg) {
    const int e = blockIdx.x;
    const int r0 = off[e] + cnt[e], r1 = off[e + 1];
    for (int r = r0; r < r1; ++r) {
        if (threadIdx.x == 0) slotw[r] = 0.f;
        for (int d = threadIdx.x; d < D; d += 256) xg[(size_t)r * D + d] = 0.f;
    }
}
__global__ void __launch_bounds__(256) k_swiglu(float* a1, const float* b3, const float* slotw, const int* off) {
    const int r = blockIdx.x;
    if (r >= off[NE]) return;
    const float w = slotw[r];
    for (int f = threadIdx.x; f < FF; f += 256) { const float a = a1[(size_t)r * FF + f]; a1[(size_t)r * FF + f] = a / (1.0f + expf(-a)) * b3[(size_t)r * FF + f] * w; }
}
__global__ void __launch_bounds__(256) k_combine(float* out, const float* y, const int* slot_of) {
    const int t = blockIdx.x; const int s0 = slot_of[t * 2], s1 = slot_of[t * 2 + 1];
    for (int d = threadIdx.x; d < D; d += 256) out[(size_t)t * D + d] += y[(size_t)s0 * D + d] + y[(size_t)s1 * D + d];
}

extern "C" void kernel_launch(void* const* d_in, const int* in_sizes, int n_in, void* d_out, int out_size, void* d_ws, size_t ws_size, hipStream_t stream) {
    if (n_in != 15 || in_sizes[0] != NT * D || out_size != NT * D || ws_size < WS_END) {
        fprintf(stderr, "kernel_launch: unexpected shapes n_in %d in0 %d out %d ws %zu\n", n_in, n_in > 0 ? in_sizes[0] : -1, out_size, ws_size);
        return;
    }
    const float* x = (const float*)d_in[0];
    const float* norm1_g = (const float*)d_in[1];
    const float* w_in = (const float*)d_in[2];
    const float* q_norm_g = (const float*)d_in[3];
    const float* k_norm_g = (const float*)d_in[4];
    const float* ln_w = (const float*)d_in[5];
    const float* ln_b = (const float*)d_in[6];
    const float* ret_g = (const float*)d_in[7];
    const float* w_out = (const float*)d_in[8];
    const float* norm2_g = (const float*)d_in[9];
    const float* w_group = (const float*)d_in[10];
    const float* w_router = (const float*)d_in[11];
    const float* w1 = (const float*)d_in[12];
    const float* w3 = (const float*)d_in[13];
    const float* w2 = (const float*)d_in[14];
    float* out = (float*)d_out;
    char* ws = (char*)d_ws;
    int* cnt = (int*)(ws + WS_CTL); int* fill = cnt + 32; int* off = cnt + 64; int* tile_e = cnt + 256;
    unsigned* thr = (unsigned*)(ws + WS_THR);
    int* eid = (int*)(ws + WS_EID); float* ew = (float*)(ws + WS_EW); int* slot_of = (int*)(ws + WS_SLOT); float* slotw = (float*)(ws + WS_SLOTW);
    float2* rot = (float2*)(ws + WS_ROT);
    float* H = (float*)(ws + WS_H); float* proj = (float*)(ws + WS_PROJ); float* I = (float*)(ws + WS_I); float* cat = (float*)(ws + WS_CAT);
    float* xg = (float*)(ws + WS_XG); float* a1 = (float*)(ws + WS_A1); float* b3 = (float*)(ws + WS_B3);

    hipMemsetAsync(ws + WS_CTL, 0, 1024, stream);
    k_rot_table<<<512, 256, 0, stream>>>(rot);
    k_rmsnorm<<<NT, 256, 0, stream>>>(x, norm1_g, H);
    k_gemm_f32<<<dim3((INW + 63) / 64, NT / 64), 256, 0, stream>>>(H, D, w_in, INW, proj, INW, INW, D, nullptr, 0, nullptr, 0);
    k_postproj<<<NT, 256, 0, stream>>>(proj, q_norm_g, k_norm_g, ln_w, ln_b, rot);
    k_index<<<NT, 256, 0, stream>>>(proj, I);
    k_thresh<<<NT, 256, 0, stream>>>(I, thr);
    k_attn<<<NT, 256, 0, stream>>>(proj, I, thr, cat);
    k_ret<<<NT, 256, 0, stream>>>(proj, ret_g, cat);
    k_gemm_f32<<<dim3(D / 64, NT / 64), 256, 0, stream>>>(cat, D, w_out, D, out, D, D, D, x, D, nullptr, 0);
    k_router<<<NT, 256, 0, stream>>>(out, norm2_g, w_group, w_router, H, eid, ew, cnt);
    k_offsets<<<1, 64, 0, stream>>>(cnt, off, tile_e);
    k_fill<<<NT, 256, 0, stream>>>(H, eid, ew, off, fill, slot_of, slotw, xg);
    k_padzero<<<NE, 256, 0, stream>>>(cnt, off, slotw, xg);
    k_gemm_f32<<<dim3(FF / 64, MAXTILES), 256, 0, stream>>>(xg, D, w1, FF, a1, FF, FF, D, nullptr, 0, tile_e, (size_t)D * FF);
    k_gemm_f32<<<dim3(FF / 64, MAXTILES), 256, 0, stream>>>(xg, D, w3, FF, b3, FF, FF, D, nullptr, 0, tile_e, (size_t)D * FF);
    k_swiglu<<<MAXROWS, 256, 0, stream>>>(a1, b3, slotw, off);
    k_gemm_f32<<<dim3(D / 64, MAXTILES), 256, 0, stream>>>(a1, FF, w2, D, xg, D, D, FF, nullptr, 0, tile_e, (size_t)FF * D);
    k_combine<<<NT, 256, 0, stream>>>(out, xg, slot_of);
}
```

```cpp
#include <hip/hip_runtime.h>
#include <hip/hip_cooperative_groups.h>
#include <cstdint>
#include <cstdio>
namespace cg = cooperative_groups;

namespace cfg {
constexpr int B = 4, S = 2048, D = 2048, NT = B * S;
constexpr int INW = 6736;
constexpr int OQ = 0, OKK = 1024, OV = 1280, OIQ = 1536, OIK = 2560, OIW = 2624, ORQ = 2640, ORK = 3664, ORV = 4688, ORG = 5712;
constexpr int NE = 32, FF = 512;
constexpr float EPS = 1e-6f;
constexpr int MAXROWS = 16384 + 32 * 64;
constexpr int MAXTILES = MAXROWS / 64;
constexpr int NTHR = 512;
constexpr int LDS_BYTES = 147456;
constexpr int SUB_LDS = 65536;
}
using namespace cfg;

constexpr size_t MiB = 1u << 20;
constexpr size_t WS_CTL = 0;
constexpr size_t WS_THR = 64 * 1024;
constexpr size_t WS_EID = 128 * 1024;
constexpr size_t WS_EW = 192 * 1024;
constexpr size_t WS_SLOT = 256 * 1024;
constexpr size_t WS_SLOTW = 320 * 1024;
constexpr size_t WS_ROT = 1 * MiB;
constexpr size_t WS_H = 2 * MiB;
constexpr size_t WS_PROJ = 66 * MiB;
constexpr size_t WS_I = 280 * MiB;
constexpr size_t WS_CAT = 344 * MiB;
constexpr size_t WS_XG = 66 * MiB;
constexpr size_t WS_A1 = 210 * MiB;
constexpr size_t WS_B3 = 246 * MiB;
constexpr size_t WS_END = 408 * MiB;

struct Params {
    const float *x, *norm1_g, *w_in, *q_norm_g, *k_norm_g, *ln_w, *ln_b, *ret_g, *w_out, *norm2_g, *w_group, *w_router, *w1, *w3, *w2;
    float* out;
    char* ws;
};

__device__ __forceinline__ float wave_sum(float v) {
#pragma unroll
    for (int o = 1; o < 64; o <<= 1) v += __shfl_xor(v, o);
    return v;
}
__device__ __forceinline__ float wave_max(float v) {
#pragma unroll
    for (int o = 1; o < 64; o <<= 1) v = fmaxf(v, __shfl_xor(v, o));
    return v;
}
__device__ __forceinline__ float block_sum(float v, float* red, int tid) {
    v = wave_sum(v);
    __syncthreads();
    if ((tid & 63) == 0) red[tid >> 6] = v;
    __syncthreads();
    return red[0] + red[1] + red[2] + red[3];
}
__device__ __forceinline__ float block_max(float v, float* red, int tid) {
    v = wave_max(v);
    __syncthreads();
    if ((tid & 63) == 0) red[tid >> 6] = v;
    __syncthreads();
    return fmaxf(fmaxf(red[0], red[1]), fmaxf(red[2], red[3]));
}
__device__ __forceinline__ unsigned fkey(float f) {
    unsigned u = __float_as_uint(f);
    return (u & 0x80000000u) ? ~u : (u | 0x80000000u);
}

__device__ __forceinline__ void nv_rmsnorm(int t, int tid, float* sm, const float* x, const float* g, float* out) {
    const float* xr = x + (size_t)t * D;
    float v[8], ss = 0.f;
#pragma unroll
    for (int j = 0; j < 8; ++j) { v[j] = xr[tid + 256 * j]; ss += v[j] * v[j]; }
    ss = block_sum(ss, sm, tid);
    const float r = rsqrtf(ss * (1.0f / D) + EPS);
#pragma unroll
    for (int j = 0; j < 8; ++j) out[(size_t)t * D + tid + 256 * j] = v[j] * r * g[tid + 256 * j];
}

__device__ __forceinline__ void nv_gemm_tile(bool active, int m0, int n0, int tid, float* sm, const float* A, int lda, const float* Bm, int ldb, float* C, int ldc,
                                             int N, int K, const float* R, int ldr) {
    float* As = sm;
    float* Bs = sm + 16 * 65;
    const int tx = tid & 15, ty = tid >> 4;
    float acc[4][4];
#pragma unroll
    for (int i = 0; i < 4; ++i)
#pragma unroll
        for (int j = 0; j < 4; ++j) acc[i][j] = 0.f;
    for (int k0 = 0; k0 < K; k0 += 16) {
        if (active) {
#pragma unroll
            for (int q = 0; q < 4; ++q) { int i = tid + 256 * q; int r = i >> 4, c = i & 15; As[c * 65 + r] = A[(size_t)(m0 + r) * lda + k0 + c]; }
#pragma unroll
            for (int q = 0; q < 4; ++q) { int i = tid + 256 * q; int r = i >> 6, c = i & 63; int n = n0 + c; Bs[r * 64 + c] = (n < N) ? Bm[(size_t)(k0 + r) * ldb + n] : 0.f; }
        }
        __syncthreads();
        if (active) {
#pragma unroll
            for (int kk = 0; kk < 16; ++kk) {
                float a[4], b[4];
#pragma unroll
                for (int i = 0; i < 4; ++i) a[i] = As[kk * 65 + ty * 4 + i];
#pragma unroll
                for (int j = 0; j < 4; ++j) b[j] = Bs[kk * 64 + tx * 4 + j];
#pragma unroll
                for (int i = 0; i < 4; ++i)
#pragma unroll
                    for (int j = 0; j < 4; ++j) acc[i][j] += a[i] * b[j];
            }
        }
        __syncthreads();
    }
    if (active) {
#pragma unroll
        for (int i = 0; i < 4; ++i)
#pragma unroll
            for (int j = 0; j < 4; ++j) {
                int m = m0 + ty * 4 + i, n = n0 + tx * 4 + j;
                if (n < N) { float v = acc[i][j]; if (R) v += R[(size_t)m * ldr + n]; C[(size_t)m * ldc + n] = v; }
            }
    }
}
__device__ __forceinline__ void nv_gemm_phase(int sub, int tid, float* sm, const float* A, int lda, const float* Bm, int ldb, float* C, int ldc,
                                              int M, int N, int K, const float* R, int ldr, const int* tile_e, size_t strideB) {
    const int ntn = (N + 63) / 64, ntm = M / 64, total = ntn * ntm;
    const int nsb = gridDim.x * 2, iters = (total + nsb - 1) / nsb;
    for (int it = 0; it < iters; ++it) {
        const int tile = (it * gridDim.x + blockIdx.x) * 2 + sub;
        bool active = tile < total;
        const int mt = active ? tile / ntn : 0, nt = active ? tile % ntn : 0;
        const float* Bp = Bm;
        if (tile_e && active) { const int e = tile_e[mt]; if (e < 0) active = false; else Bp = Bm + (size_t)e * strideB; }
        nv_gemm_tile(active, mt * 64, nt * 64, tid, sm, A, lda, Bp, ldb, C, ldc, N, K, R, ldr);
    }
}

__device__ __forceinline__ void nv_postproj(int t, int tid, float* proj, const float* qg, const float* kg, const float* lnw, const float* lnb, const float2* rot) {
    const int tl = t & (S - 1);
    float* p = proj + (size_t)t * INW;
    const int w = tid >> 6, lane = tid & 63;
    for (int h = w; h < 8; h += 4) {
        float* q = p + OQ + h * 128; float a = q[lane], b = q[lane + 64];
        float ss = wave_sum(a * a + b * b); float r = rsqrtf(ss * (1.0f / 128) + EPS);
        q[lane] = a * r * qg[lane]; q[lane + 64] = b * r * qg[lane + 64];
    }
    if (w < 2) {
        float* q = p + OKK + w * 128; float a = q[lane], b = q[lane + 64];
        float ss = wave_sum(a * a + b * b); float r = rsqrtf(ss * (1.0f / 128) + EPS);
        q[lane] = a * r * kg[lane]; q[lane + 64] = b * r * kg[lane + 64];
    }
    if (w == 2) {
        float v = p[OIK + lane]; float mean = wave_sum(v) * (1.0f / 64); float d = v - mean;
        float var = wave_sum(d * d) * (1.0f / 64);
        p[OIK + lane] = d * rsqrtf(var + EPS) * lnw[lane] + lnb[lane];
    }
    if (w == 3 && lane < 16) p[OIW + lane] *= 0.03125f;
    for (int it = w; it < 16; it += 4) {
        const int which = it >> 3, h = it & 7;
        float* r = p + (which ? ORK : ORQ) + h * 128;
        const float2 cs = rot[tl * 64 + lane];
        const float x1 = r[lane], x2 = r[lane + 64];
        const float sc = which ? 0.08838834764831845f : 1.f;
        r[lane] = (x1 * cs.x - x2 * cs.y) * sc; r[lane + 64] = (x1 * cs.y + x2 * cs.x) * sc;
    }
}

__device__ __forceinline__ void nv_index(int t, int tid, float* sm, const float* proj, float* I) {
    float* siq = sm; float* siw = sm + 1024;
    const int tl = t & (S - 1), b0 = t - tl;
    const float* p = proj + (size_t)t * INW;
    __syncthreads();
    for (int i = tid; i < 1024; i += 256) siq[i] = p[OIQ + i];
    if (tid < 16) siw[tid] = p[OIW + tid];
    __syncthreads();
    const int nvis = 64 * (tl / 64 + 1);
    for (int s = tid; s < S; s += 256) {
        float out = -INFINITY;
        if (s < nvis) {
            const float* kp = proj + (size_t)(b0 + s) * INW + OIK;
            float kk[64];
#pragma unroll
            for (int d = 0; d < 64; ++d) kk[d] = kp[d];
            float acc = 0.f;
            for (int h = 0; h < 16; ++h) {
                float dot = 0.f;
#pragma unroll
                for (int d = 0; d < 64; ++d) dot += siq[h * 64 + d] * kk[d];
                acc += siw[h] * fmaxf(dot, 0.f);
            }
            out = acc;
        }
        I[(size_t)t * S + s] = out;
    }
}

__device__ __forceinline__ void nv_thresh(int t, int tid, float* sm, const float* I, unsigned* thr) {
    unsigned key[8];
#pragma unroll
    for (int j = 0; j < 8; ++j) key[j] = fkey(I[(size_t)t * S + tid + 256 * j]);
    unsigned T = 0;
    for (int bit = 31; bit >= 0; --bit) {
        const unsigned cand = T | (1u << bit);
        float c = 0.f;
#pragma unroll
        for (int j = 0; j < 8; ++j) c += (key[j] >= cand) ? 1.f : 0.f;
        c = block_sum(c, sm, tid);
        if (c >= 256.f) T = cand;
    }
    if (tid == 0) thr[t] = T;
}

__device__ __forceinline__ void nv_attn(int t, int tid, float* sm, const float* proj, const float* I, const unsigned* thr, float* cat) {
    float* red = sm; float* sq = sm + 16; float* sc = sm + 16 + 512;
    const int tl = t & (S - 1), b0 = t - tl;
    const int nvis = 64 * (tl / 64 + 1);
    const unsigned T = thr[t];
    const float* p = proj + (size_t)t * INW;
    for (int g = 0; g < 2; ++g) {
        __syncthreads();
        for (int i = tid; i < 512; i += 256) sq[i] = p[OQ + g * 512 + i];
        __syncthreads();
        for (int s = tid; s < nvis; s += 256) {
            const bool sel = fkey(I[(size_t)t * S + s]) >= T;
            float d0 = -INFINITY, d1 = -INFINITY, d2 = -INFINITY, d3 = -INFINITY;
            if (sel) {
                const float* kp = proj + (size_t)(b0 + s) * INW + OKK + g * 128;
                d0 = d1 = d2 = d3 = 0.f;
                for (int d = 0; d < 128; ++d) { const float kv = kp[d]; d0 += sq[d] * kv; d1 += sq[128 + d] * kv; d2 += sq[256 + d] * kv; d3 += sq[384 + d] * kv; }
                const float scl = 0.08838834764831845f;
                d0 *= scl; d1 *= scl; d2 *= scl; d3 *= scl;
            }
            sc[s] = d0; sc[2048 + s] = d1; sc[4096 + s] = d2; sc[6144 + s] = d3;
        }
        __syncthreads();
        float inv[4];
#pragma unroll
        for (int hh = 0; hh < 4; ++hh) {
            float m = -INFINITY;
            for (int s = tid; s < nvis; s += 256) m = fmaxf(m, sc[hh * 2048 + s]);
            m = block_max(m, red, tid);
            float sum = 0.f;
            for (int s = tid; s < nvis; s += 256) { const float v = sc[hh * 2048 + s]; const float e = (v == -INFINITY) ? 0.f : expf(v - m); sc[hh * 2048 + s] = e; sum += e; }
            sum = block_sum(sum, red, tid);
            inv[hh] = 1.0f / sum;
        }
        __syncthreads();
        const int d = tid & 127, half = tid >> 7;
#pragma unroll
        for (int rep = 0; rep < 2; ++rep) {
            const int hh = half + 2 * rep;
            float acc = 0.f;
            for (int s = 0; s < nvis; ++s) {
                const float pe = sc[hh * 2048 + s];
                if (pe != 0.f) acc += pe * proj[(size_t)(b0 + s) * INW + OV + g * 128 + d];
            }
            cat[(size_t)t * D + (g * 4 + hh) * 128 + d] = acc * (half == 0 ? (rep == 0 ? inv[0] : inv[2]) : (rep == 0 ? inv[1] : inv[3]));
        }
    }
}

__device__ __forceinline__ void nv_ret(int t, int tid, float* sm, const float* proj, const float* rng, float* cat) {
    float* red = sm; float* sq = sm + 16; float* comb = sm + 16 + 128; float* sw = sm + 16 + 128 + 256;
    const int tl = t & (S - 1), b0 = t - tl;
    const float* p = proj + (size_t)t * INW;
    for (int h = 0; h < 8; ++h) {
        __syncthreads();
        if (tid < 128) sq[tid] = p[ORQ + h * 128 + tid];
        __syncthreads();
        const float lg = log1pf(-exp2f(-5.0f - (float)h));
        for (int m = tid; m <= tl; m += 256) {
            const float* kp = proj + (size_t)(b0 + m) * INW + ORK + h * 128;
            float dot = 0.f;
            for (int d = 0; d < 128; ++d) dot += sq[d] * kp[d];
            sw[m] = dot * expf(lg * (float)(tl - m));
        }
        __syncthreads();
        const int e = tid & 127, half = tid >> 7;
        float acc = 0.f;
        for (int m = half; m <= tl; m += 2) acc += sw[m] * proj[(size_t)(b0 + m) * INW + ORV + h * 128 + e];
        comb[tid] = acc;
        __syncthreads();
        float o = comb[e] + comb[e + 128];
        float ss = block_sum(half == 0 ? o * o : 0.f, red, tid);
        if (half == 0) {
            const float y = o * rsqrtf(ss * (1.0f / 128) + EPS) * rng[h * 128 + e];
            const float gt = p[ORG + h * 128 + e];
            cat[(size_t)t * D + 1024 + h * 128 + e] = gt / (1.0f + expf(-gt)) * y;
        }
    }
}

__device__ __forceinline__ void nv_router(int t, int tid, float* sm, const float* x1, const float* g2, const float* wg, const float* wr, float* h2, int* eid, float* ew, int* cnt) {
    float* red = sm; float* lg = sm + 16;
    float v[8], ss = 0.f;
#pragma unroll
    for (int j = 0; j < 8; ++j) { v[j] = x1[(size_t)t * D + tid + 256 * j]; ss += v[j] * v[j]; }
    ss = block_sum(ss, red, tid);
    const float r = rsqrtf(ss * (1.0f / D) + EPS);
#pragma unroll
    for (int j = 0; j < 8; ++j) { v[j] = v[j] * r * g2[tid + 256 * j]; h2[(size_t)t * D + tid + 256 * j] = v[j]; }
    for (int c = 0; c < 36; ++c) {
        float pa = 0.f;
#pragma unroll
        for (int j = 0; j < 8; ++j) {
            const int d = tid + 256 * j;
            const float w = (c < 4) ? wg[d * 4 + c] : wr[((size_t)((c - 4) >> 3) * D + d) * 8 + ((c - 4) & 7)];
            pa += v[j] * w;
        }
        pa = block_sum(pa, red, tid);
        if (tid == 0) lg[c] = pa;
    }
    __syncthreads();
    if (tid == 0) {
        int gs = 0; for (int c = 1; c < 4; ++c) if (lg[c] > lg[gs]) gs = c;
        float den = 0.f; for (int c = 0; c < 4; ++c) den += expf(lg[c] - lg[gs]);
        const float gate = 1.0f / den;
        const float* el = lg + 4 + gs * 8;
        int i0 = 0; for (int c = 1; c < 8; ++c) if (el[c] > el[i0]) i0 = c;
        int i1 = -1; for (int c = 0; c < 8; ++c) if (c != i0 && (i1 < 0 || el[c] > el[i1])) i1 = c;
        const float e1 = expf(el[i1] - el[i0]);
        const float w0 = 1.0f / (1.0f + e1) * gate, w1 = e1 / (1.0f + e1) * gate;
        eid[t * 2] = gs * 8 + i0; eid[t * 2 + 1] = gs * 8 + i1; ew[t * 2] = w0; ew[t * 2 + 1] = w1;
        atomicAdd(&cnt[gs * 8 + i0], 1); atomicAdd(&cnt[gs * 8 + i1], 1);
    }
}

__device__ __forceinline__ void nv_fill(int t, int tid, float* sm, const int* soff, const float* h2, const int* eid, const float* ew, int* fill, int* slot_of, float* slotw, float* xg) {
    int* sslot = (int*)sm;
    __syncthreads();
    if (tid < 2) {
        const int e = eid[t * 2 + tid];
        const int slot = soff[e] + atomicAdd(&fill[e], 1);
        sslot[tid] = slot; slot_of[t * 2 + tid] = slot; slotw[slot] = ew[t * 2 + tid];
    }
    __syncthreads();
    for (int k = 0; k < 2; ++k)
        for (int d = tid; d < D; d += 256) xg[(size_t)sslot[k] * D + d] = h2[(size_t)t * D + d];
}

__global__ void __launch_bounds__(NTHR, 2) mega(Params P) {
    extern __shared__ __attribute__((aligned(16))) unsigned char lds[];
    cg::grid_group grid = cg::this_grid();
    const int sub = threadIdx.x >> 8, tid = threadIdx.x & 255;
    float* sm = (float*)(lds + sub * SUB_LDS);
    int* soff = (int*)(lds + 2 * SUB_LDS);
    const int G = gridDim.x, nsb = G * 2, sb = blockIdx.x * 2 + sub;
    char* ws = P.ws;
    int* cnt = (int*)(ws + WS_CTL); int* fill = cnt + 32; int* off = cnt + 64; int* tile_e = cnt + 256;
    unsigned* thr = (unsigned*)(ws + WS_THR);
    int* eid = (int*)(ws + WS_EID); float* ew = (float*)(ws + WS_EW); int* slot_of = (int*)(ws + WS_SLOT); float* slotw = (float*)(ws + WS_SLOTW);
    float2* rot = (float2*)(ws + WS_ROT);
    float* H = (float*)(ws + WS_H); float* proj = (float*)(ws + WS_PROJ); float* I = (float*)(ws + WS_I); float* cat = (float*)(ws + WS_CAT);
    float* xg = (float*)(ws + WS_XG); float* a1 = (float*)(ws + WS_A1); float* b3 = (float*)(ws + WS_B3);

    for (int idx = blockIdx.x * NTHR + threadIdx.x; idx < 2048 * 64; idx += G * NTHR) {
        const int pos = idx >> 6, i = idx & 63;
        const double inv = exp(-log(10000.0) * (double)i / 63.0);
        const double ang = (double)pos * inv;
        rot[idx] = make_float2((float)cos(ang), (float)sin(ang));
    }
    for (int t = sb; t < NT; t += nsb) nv_rmsnorm(t, tid, sm, P.x, P.norm1_g, H);
    grid.sync();
    nv_gemm_phase(sub, tid, sm, H, D, P.w_in, INW, proj, INW, NT, INW, D, nullptr, 0, nullptr, 0);
    grid.sync();
    for (int t = sb; t < NT; t += nsb) nv_postproj(t, tid, proj, P.q_norm_g, P.k_norm_g, P.ln_w, P.ln_b, rot);
    grid.sync();
    for (int t = sb; t < NT; t += nsb) {
        nv_index(t, tid, sm, proj, I);
        __syncthreads();
        nv_thresh(t, tid, sm, I, thr);
        __syncthreads();
        nv_attn(t, tid, sm, proj, I, thr, cat);
        nv_ret(t, tid, sm, proj, P.ret_g, cat);
    }
    grid.sync();
    nv_gemm_phase(sub, tid, sm, cat, D, P.w_out, D, P.out, D, NT, D, D, P.x, D, nullptr, 0);
    grid.sync();
    for (int t = sb; t < NT; t += nsb) nv_router(t, tid, sm, P.out, P.norm2_g, P.w_group, P.w_router, H, eid, ew, cnt);
    grid.sync();
    if (threadIdx.x == 0) {
        int o = 0;
        for (int e = 0; e < NE; ++e) {
            soff[e] = o; const int nt = (cnt[e] + 63) / 64;
            if (blockIdx.x == 0) { off[e] = o; for (int i = 0; i < nt; ++i) tile_e[o / 64 + i] = e; }
            o += nt * 64;
        }
        soff[NE] = o;
        if (blockIdx.x == 0) { off[NE] = o; for (int i = o / 64; i < MAXTILES; ++i) tile_e[i] = -1; }
    }
    __syncthreads();
    for (int t = sb; t < NT; t += nsb) nv_fill(t, tid, sm, soff, H, eid, ew, fill, slot_of, slotw, xg);
    for (int e = blockIdx.x; e < NE; e += G) {
        const int r0 = soff[e] + cnt[e], r1 = soff[e + 1];
        for (int r = r0; r < r1; ++r) {
            if (threadIdx.x == 0) slotw[r] = 0.f;
            for (int d = threadIdx.x; d < D; d += NTHR) xg[(size_t)r * D + d] = 0.f;
        }
    }
    grid.sync();
    nv_gemm_phase(sub, tid, sm, xg, D, P.w1, FF, a1, FF, MAXROWS, FF, D, nullptr, 0, tile_e, (size_t)D * FF);
    nv_gemm_phase(sub, tid, sm, xg, D, P.w3, FF, b3, FF, MAXROWS, FF, D, nullptr, 0, tile_e, (size_t)D * FF);
    grid.sync();
    {
        const int nrows = off[NE];
        for (int r = sb; r < nrows; r += nsb) {
            const float w = slotw[r];
            for (int f = tid; f < FF; f += 256) { const float a = a1[(size_t)r * FF + f]; a1[(size_t)r * FF + f] = a / (1.0f + expf(-a)) * b3[(size_t)r * FF + f] * w; }
        }
    }
    grid.sync();
    nv_gemm_phase(sub, tid, sm, a1, FF, P.w2, D, xg, D, MAXROWS, D, FF, nullptr, 0, tile_e, (size_t)FF * D);
    grid.sync();
    for (int t = sb; t < NT; t += nsb) {
        const int s0 = slot_of[t * 2], s1 = slot_of[t * 2 + 1];
        for (int d = tid; d < D; d += 256) P.out[(size_t)t * D + d] += xg[(size_t)s0 * D + d] + xg[(size_t)s1 * D + d];
    }
}

extern "C" void kernel_launch(void* const* d_in, const int* in_sizes, int n_in, void* d_out, int out_size, void* d_ws, size_t ws_size, hipStream_t stream) {
    static int grid_blocks = 0;
    if (grid_blocks == 0) {
        if (n_in != 15 || in_sizes[0] != NT * D || out_size != NT * D || ws_size < WS_END) {
            fprintf(stderr, "kernel_launch: unexpected shapes n_in %d in0 %d out %d ws %zu\n", n_in, n_in > 0 ? in_sizes[0] : -1, out_size, ws_size);
            grid_blocks = -1; return;
        }
        int dev = 0, cus = 0, per_cu = 0;
        (void)hipGetDevice(&dev);
        (void)hipDeviceGetAttribute(&cus, hipDeviceAttributeMultiprocessorCount, dev);
        (void)hipFuncSetAttribute((const void*)mega, hipFuncAttributeMaxDynamicSharedMemorySize, LDS_BYTES);
        (void)hipOccupancyMaxActiveBlocksPerMultiprocessor(&per_cu, (const void*)mega, NTHR, LDS_BYTES);
        if (per_cu < 1) { fprintf(stderr, "kernel_launch: occupancy query says %d blocks/CU\n", per_cu); per_cu = 1; }
        if (per_cu > 1) per_cu = 1;
        grid_blocks = 1; while (grid_blocks * 2 <= cus * per_cu) grid_blocks *= 2;
        fprintf(stderr, "kernel_launch: grid %d (cus %d)\n", grid_blocks, cus);
    }
    if (grid_blocks < 0) return;
    (void)hipMemsetAsync((char*)d_ws + WS_CTL, 0, 1024, stream);
    Params p{};
    p.x = (const float*)d_in[0]; p.norm1_g = (const float*)d_in[1]; p.w_in = (const float*)d_in[2]; p.q_norm_g = (const float*)d_in[3];
    p.k_norm_g = (const float*)d_in[4]; p.ln_w = (const float*)d_in[5]; p.ln_b = (const float*)d_in[6]; p.ret_g = (const float*)d_in[7];
    p.w_out = (const float*)d_in[8]; p.norm2_g = (const float*)d_in[9]; p.w_group = (const float*)d_in[10]; p.w_router = (const float*)d_in[11];
    p.w1 = (const float*)d_in[12]; p.w3 = (const float*)d_in[13]; p.w2 = (const float*)d_in[14];
    p.out = (float*)d_out; p.ws = (char*)d_ws;
    void* args[] = {&p};
    hipError_t e = hipLaunchCooperativeKernel((const void*)mega, dim3(grid_blocks), dim3(NTHR), args, LDS_BYTES, stream);
    if (e != hipSuccess) fprintf(stderr, "cooperative launch failed: %s (grid %d)\n", hipGetErrorString(e), grid_blocks);
}
```

```cpp
#include <hip/hip_runtime.h>
#include <hip/hip_cooperative_groups.h>
#include <cstdint>
#include <cstdio>
namespace cg = cooperative_groups;
__device__ __forceinline__ int otid() { int t = threadIdx.x; asm volatile("" : "+v"(t)); return t; }

namespace cfg {
constexpr int B = 4, S = 2048, D = 2048, NT = B * S;
constexpr int INW = 6736, LDP = 6912;
constexpr int OQ = 0, OKK = 1024, OV = 1280, OIQ = 1536, OIK = 2560, OIW = 2624, ORQ = 2640, ORK = 3664, ORV = 4688, ORG = 5712;
constexpr int NE = 32, FF = 512;
constexpr float EPS = 1e-6f;
constexpr int MAXROWS = 16384 + 32 * 256;
constexpr int MAXTILES = MAXROWS / 256;
constexpr int NTHR = 512, NWAVES = 8;
constexpr int LDS_BYTES = 147456;
constexpr int SUB_LDS = 65536;
}
using namespace cfg;

constexpr size_t MiB = 1u << 20;
constexpr size_t WS_CTL = 0;
constexpr size_t WS_THR = 64 * 1024;
constexpr size_t WS_EID = 128 * 1024;
constexpr size_t WS_EW = 192 * 1024;
constexpr size_t WS_SLOT = 256 * 1024;
constexpr size_t WS_SLOTW = 320 * 1024;
constexpr size_t WS_IWF = 448 * 1024;
constexpr size_t WS_ROT = 1 * MiB;
constexpr size_t WS_WINT = 2 * MiB;
constexpr size_t WS_WOUTT = 29 * MiB;
constexpr size_t WS_W13T = 37 * MiB;
constexpr size_t WS_W2T = 165 * MiB;
constexpr size_t WS_XN = 229 * MiB;
constexpr size_t WS_PROJB = 261 * MiB;
constexpr size_t WS_CATB = 369 * MiB;
constexpr size_t WS_MASK = 401 * MiB;
constexpr size_t WS_IKC = 403 * MiB;
constexpr size_t WS_KVT = 404 * MiB;
constexpr size_t WS_RT = WS_XN;
constexpr size_t WS_END = 468 * MiB;

struct Params {
    const float *x, *norm1_g, *w_in, *q_norm_g, *k_norm_g, *ln_w, *ln_b, *ret_g, *w_out, *norm2_g, *w_group, *w_router, *w1, *w3, *w2;
    float* out;
    char* ws;
};
namespace pg8 {
#define PG8_LAS __attribute__((address_space(3)))
typedef unsigned short bf16_t;
typedef short bf16x8 __attribute__((ext_vector_type(8)));
typedef float f32x4 __attribute__((ext_vector_type(4)));
typedef unsigned u32x4 __attribute__((ext_vector_type(4)));
constexpr int BM = 256, BK = 64, HALF = 128, HTB = HALF * BK * 2  , STAGE_BYTES = 8 * HTB, NXCD = 8, WGM = 8;

__host__ __device__ __forceinline__ int lds_byte(int r, int c) { const int st = (r >> 4) * 2 + (c >> 5), rr = r & 15, cc = c & 31, ob = rr * 64 + cc * 2; return st * 1024 + (ob ^ (((ob >> 9) & 1) << 5)); }
__host__ __device__ __forceinline__ void stage_rc(int b, int& R, int& C) { const int st = b / 1024, sb = b % 1024, swz = sb ^ (((sb >> 9) & 1) << 5); R = (st >> 1) * 16 + swz / 64; C = (st & 1) * 32 + (swz % 64) / 2; }
__host__ __device__ __forceinline__ int perm32(int rho) { const int n = rho >> 4, i = rho & 15; return 8 * (i >> 2) + 4 * n + (i & 3); }

struct Unit { int pm, pn; };
struct Gemm { const bf16_t* A; const bf16_t* Bt; int M, N, K; };

struct StaticOrder {
    int nM, nN, nwg, G, c;
    __host__ __device__ void init(int M, int N, int G_, int c_) { nM = M / BM; nN = N / BM; nwg = nM * nN; G = G_; c = c_; }
    __host__ __device__ bool next(int i, Unit& u) const {
        const long L = (long)i * G + c; if (L >= nwg) return false;
        int wgid = (int)L; { const int q = nwg / NXCD, r = nwg % NXCD, xcd = wgid % NXCD, off = wgid / NXCD; wgid = (xcd < r ? xcd * (q + 1) : r * (q + 1) + (xcd - r) * q) + off; }
        const int nig = WGM * nN, gid = wgid / nig, fm = gid * WGM, gsz = (nM - fm) < WGM ? (nM - fm) : WGM;
        u.pm = fm + ((wgid % nig) % gsz); u.pn = (wgid % nig) / gsz; return true;
    }
    __device__ __forceinline__ void a_ready(const Unit&) const {}
    __device__ __forceinline__ void done(const Unit&) const {}
    __device__ __forceinline__ const bf16_t* b_base(const Unit&, const bf16_t* Bt) const { return Bt; }
};
struct GroupedOrder {
    const int* tile_e; int ntiles, nN, G, c; size_t strideB;
    __device__ __forceinline__ bool next(int i, Unit& u) const { const long L = (long)i * G + c; if (L >= (long)ntiles * nN) return false; u.pm = (int)(L / nN); u.pn = (int)(L % nN); return true; }
    __device__ __forceinline__ void a_ready(const Unit&) const {}
    __device__ __forceinline__ void done(const Unit&) const {}
    __device__ __forceinline__ const bf16_t* b_base(const Unit& u, const bf16_t* Bt) const { return Bt + (size_t)tile_e[u.pm] * strideB; }
};


__device__ __forceinline__ unsigned cvt_pk_bf16(float lo, float hi) { unsigned r; asm volatile("v_cvt_pk_bf16_f32 %0, %1, %2" : "=v"(r) : "v"(lo), "v"(hi)); return r; }
struct EpiBf16 {
    static constexpr bool PERM = true, AFTER_DRAIN = false;
    bf16_t* O; int ldc;
    __device__ __forceinline__ void operator()(const f32x4 (&acc)[2][2][4][2], const Unit& u, int wr, int wc, int fr, int fq) const {
        const int row0 = u.pm * BM + wr * 64 + fr; const int col0 = u.pn * BM + wc * 32 + 8 * fq;
#pragma unroll
        for (int ai = 0; ai < 2; ++ai)
#pragma unroll
            for (int m = 0; m < 4; ++m) { bf16_t* rowp = O + (size_t)(row0 + ai * HALF + m * 16) * ldc + col0;
#pragma unroll
                for (int bj = 0; bj < 2; ++bj) { const f32x4 v0 = acc[ai][bj][m][0], v1 = acc[ai][bj][m][1];
                    u32x4 w; w.x = cvt_pk_bf16(v0[0], v0[1]); w.y = cvt_pk_bf16(v0[2], v0[3]); w.z = cvt_pk_bf16(v1[0], v1[1]); w.w = cvt_pk_bf16(v1[2], v1[3]);
                    *(u32x4*)(rowp + bj * HALF) = w; } }
    }
};
struct EpiF32Res {
    static constexpr bool PERM = false, AFTER_DRAIN = false;
    const float* base; float* out; int ldc;
    __device__ __forceinline__ void operator()(const f32x4 (&acc)[2][2][4][2], const Unit& u, int wr, int wc, int fr, int fq) const {
        const int col0 = u.pn * BM + wc * 32 + 4 * fq;
#pragma unroll
        for (int ai = 0; ai < 2; ++ai)
#pragma unroll
            for (int m = 0; m < 4; ++m) { const size_t off = (size_t)(u.pm * BM + ai * HALF + wr * 64 + m * 16 + fr) * ldc + col0;
#pragma unroll
                for (int bj = 0; bj < 2; ++bj)
#pragma unroll
                    for (int n = 0; n < 2; ++n) { const f32x4 bs = *(const f32x4*)(base + off + bj * HALF + n * 16); *(f32x4*)(out + off + bj * HALF + n * 16) = bs + acc[ai][bj][m][n]; } }
    }
};
struct EpiSwiglu {
    static constexpr bool PERM = true, AFTER_DRAIN = false;
    bf16_t* O; int ldc; const float* roww;
    __device__ __forceinline__ void operator()(const f32x4 (&acc)[2][2][4][2], const Unit& u, int wr, int wc, int fr, int fq) const {
        const int row0 = u.pm * BM + wr * 64 + fr; const int col0 = u.pn * HALF + wc * 32 + 8 * fq;
#pragma unroll
        for (int ai = 0; ai < 2; ++ai)
#pragma unroll
            for (int m = 0; m < 4; ++m) { const int row = row0 + ai * HALF + m * 16; const float w = roww[row];
                float h[8];
#pragma unroll
                for (int n = 0; n < 2; ++n)
#pragma unroll
                    for (int j = 0; j < 4; ++j) { const float a = acc[ai][0][m][n][j], b = acc[ai][1][m][n][j]; h[n * 4 + j] = a * __builtin_amdgcn_rcpf(1.0f + __expf(-a)) * b * w; }
                u32x4 o; o.x = cvt_pk_bf16(h[0], h[1]); o.y = cvt_pk_bf16(h[2], h[3]); o.z = cvt_pk_bf16(h[4], h[5]); o.w = cvt_pk_bf16(h[6], h[7]);
                *(u32x4*)(O + (size_t)row * ldc + col0) = o; }
    }
};

template <class Epi, class Sched, bool ALIGN_EPI = false, bool SP2 = false>
__device__ __forceinline__ void gemm_phase(PG8_LAS unsigned char* lds, const Gemm g, const Sched& S, const Epi& E) {
    const int tid = otid(), wid = __builtin_amdgcn_readfirstlane(tid >> 6), lane = tid & 63, wr = wid >> 2, wc = wid & 3, fr = lane & 15, fq = lane >> 4;
    const int K = g.K, nt = K / BK;
    unsigned voffA[2], voffB[2];
#pragma unroll
    for (int i = 0; i < 2; ++i) { int R, C; stage_rc(tid * 16 + i * 8192, R, C); const int Rb = Epi::PERM ? ((R & ~31) + perm32(R & 31)) : R;
        voffA[i] = (unsigned)(R * K + C) * 2u; voffB[i] = (unsigned)(Rb * K + C) * 2u; }
    const size_t kstep = (size_t)(BK * 2);
    const size_t hstep = (size_t)HALF * K * 2;
    const size_t tstep = 2 * hstep;
    const unsigned ldsw = (unsigned)wid * 1024u;
    const int aoff = lds_byte(wr * 64 + fr, fq * 8), boff = lds_byte(wc * 32 + fr, fq * 8);
#define PG8_SA(b, h) (((b) * 2 + (h)) * HTB)
#define PG8_SB(b, h) ((4 + (b) * 2 + (h)) * HTB)
#define PG8_STAGE(bufoff, gbase, voff) do { _Pragma("unroll") for (int _i = 0; _i < 2; ++_i) \
        __builtin_amdgcn_global_load_lds((const unsigned*)((const char*)(gbase) + (voff)[_i]), (PG8_LAS unsigned*)(lds + (bufoff) + ldsw + _i * 8192), 16, 0, 0); } while (0)
#define PG8_LDA(dst, b, h) do { _Pragma("unroll") for (int m = 0; m < 4; ++m) _Pragma("unroll") for (int k = 0; k < 2; ++k) dst[m][k] = *(const PG8_LAS bf16x8*)(lds + PG8_SA(b, h) + aoff + m * 2048 + k * 1024); } while (0)
#define PG8_LDB(dst, b, h) do { _Pragma("unroll") for (int n = 0; n < 2; ++n) _Pragma("unroll") for (int k = 0; k < 2; ++k) dst[n][k] = *(const PG8_LAS bf16x8*)(lds + PG8_SB(b, h) + boff + n * 2048 + k * 1024); } while (0)
#define PG8_MMA(ai, bj, At, Bt) do { __builtin_amdgcn_s_setprio(1); _Pragma("unroll") for (int m = 0; m < 4; ++m) _Pragma("unroll") for (int n = 0; n < 2; ++n) _Pragma("unroll") for (int k = 0; k < 2; ++k) \
        acc[ai][bj][m][n] = __builtin_amdgcn_mfma_f32_16x16x32_bf16(Bt[n][k], At[m][k], acc[ai][bj][m][n], 0, 0, 0); __builtin_amdgcn_s_setprio(0); } while (0)
#define PG8_WAIT_V(n) asm volatile("s_waitcnt vmcnt(" #n ")" ::: "memory")
#define PG8_WAIT_L(n) asm volatile("s_waitcnt lgkmcnt(" #n ")" ::: "memory")
#define PG8_BAR __builtin_amdgcn_s_barrier()
#define PG8_SCHED __builtin_amdgcn_sched_barrier(0)
    Unit cur, nxt; int ui = 0;
    if (!S.next(0, cur)) return;
    f32x4 acc[2][2][4][2];
#pragma unroll
    for (int a = 0; a < 2; ++a)
#pragma unroll
        for (int b = 0; b < 2; ++b)
#pragma unroll
            for (int m = 0; m < 4; ++m)
#pragma unroll
                for (int n = 0; n < 2; ++n) acc[a][b][m][n] = (f32x4){0.f, 0.f, 0.f, 0.f};
    bf16x8 At[4][2], B0[2][2], B1[2][2];
    const char* cA = (const char*)g.A + (size_t)cur.pm * tstep; const char* cB = (const char*)S.b_base(cur, g.Bt) + (size_t)cur.pn * tstep;
    S.a_ready(cur);
    if constexpr (SP2) {
        PG8_STAGE(PG8_SB(0, 0), cB, voffB); PG8_STAGE(PG8_SB(0, 1), cB + hstep, voffB); PG8_STAGE(PG8_SA(0, 0), cA, voffA); PG8_STAGE(PG8_SA(0, 1), cA + hstep, voffA);
        if (wr == 1) PG8_BAR;
        PG8_WAIT_V(2); PG8_BAR;
        PG8_STAGE(PG8_SB(1, 0), cB + kstep, voffB); PG8_STAGE(PG8_SA(1, 0), cA + kstep, voffA); PG8_STAGE(PG8_SB(1, 1), cB + hstep + kstep, voffB);
        PG8_WAIT_V(6); PG8_BAR;
    } else {
        PG8_STAGE(PG8_SB(0, 0), cB, voffB); PG8_STAGE(PG8_SA(0, 0), cA, voffA); PG8_STAGE(PG8_SB(0, 1), cB + hstep, voffB); PG8_STAGE(PG8_SA(0, 1), cA + hstep, voffA);
        if (wr == 1) PG8_BAR;
        PG8_WAIT_V(4); PG8_BAR;
        PG8_STAGE(PG8_SB(1, 0), cB + kstep, voffB); PG8_STAGE(PG8_SA(1, 0), cA + kstep, voffA); PG8_STAGE(PG8_SB(1, 1), cB + hstep + kstep, voffB);
        PG8_WAIT_V(6); PG8_BAR;
    }
    for (;;) {
        const bool has_next = S.next(ui + 1, nxt);
        const char* nA = has_next ? (const char*)g.A + (size_t)nxt.pm * tstep : cA; const char* nB = has_next ? (const char*)S.b_base(nxt, g.Bt) + (size_t)nxt.pn * tstep : cB;
        for (int t = 0; t < nt; t += 2) {
            const bool last = (t == nt - 2);
            const char* a1 = cA + (size_t)(t + 1) * kstep;
            const char* a2 = last ? nA : cA + (size_t)(t + 2) * kstep; const char* b2 = last ? nB : cB + (size_t)(t + 2) * kstep;
            const char* a3 = a2 + kstep; const char* b3 = b2 + kstep;
            if (last && has_next) S.a_ready(nxt);
            if constexpr (SP2) {
            PG8_LDB(B0, 0, 0); PG8_LDB(B1, 0, 1); PG8_SCHED; PG8_LDA(At, 0, 0); PG8_STAGE(PG8_SA(1, 1), a1 + hstep, voffA);
            PG8_WAIT_V(8); PG8_WAIT_L(0); PG8_BAR; PG8_MMA(0, 0, At, B0); PG8_MMA(0, 1, At, B1); PG8_BAR; PG8_SCHED;
            PG8_LDA(At, 0, 1); PG8_STAGE(PG8_SB(0, 0), b2, voffB); PG8_STAGE(PG8_SB(0, 1), b2 + hstep, voffB); PG8_STAGE(PG8_SA(0, 0), a2, voffA);
            PG8_WAIT_V(8); PG8_WAIT_L(0); PG8_BAR; PG8_MMA(1, 0, At, B0); PG8_MMA(1, 1, At, B1); PG8_BAR; PG8_SCHED;
            PG8_LDB(B0, 1, 0); PG8_LDB(B1, 1, 1); PG8_SCHED; PG8_LDA(At, 1, 0); PG8_STAGE(PG8_SA(0, 1), a2 + hstep, voffA);
            PG8_WAIT_V(8); PG8_WAIT_L(0); PG8_BAR; PG8_MMA(0, 0, At, B0); PG8_MMA(0, 1, At, B1); PG8_BAR; PG8_SCHED;
            PG8_LDA(At, 1, 1); PG8_STAGE(PG8_SB(1, 0), b3, voffB); PG8_STAGE(PG8_SB(1, 1), b3 + hstep, voffB); PG8_STAGE(PG8_SA(1, 0), a3, voffA);
            PG8_WAIT_V(8); PG8_WAIT_L(0); PG8_BAR; PG8_MMA(1, 0, At, B0); PG8_MMA(1, 1, At, B1); PG8_BAR; PG8_SCHED;
            } else {
            PG8_LDB(B0, 0, 0); PG8_SCHED; PG8_LDA(At, 0, 0); PG8_STAGE(PG8_SA(1, 1), a1 + hstep, voffA);
            PG8_WAIT_L(8); PG8_BAR; PG8_WAIT_L(0); PG8_MMA(0, 0, At, B0); PG8_BAR; PG8_SCHED;
            PG8_LDB(B1, 0, 1); PG8_STAGE(PG8_SB(0, 0), b2, voffB);
            PG8_BAR; PG8_WAIT_L(0); PG8_MMA(0, 1, At, B1); PG8_BAR;
            PG8_LDA(At, 0, 1); PG8_STAGE(PG8_SA(0, 0), a2, voffA);
            PG8_BAR; PG8_WAIT_L(0); PG8_MMA(1, 0, At, B0); PG8_BAR; PG8_SCHED;
            PG8_STAGE(PG8_SB(0, 1), b2 + hstep, voffB);
            PG8_WAIT_V(6); PG8_BAR; PG8_MMA(1, 1, At, B1); PG8_BAR;
            PG8_LDB(B0, 1, 0); PG8_SCHED; PG8_LDA(At, 1, 0); PG8_STAGE(PG8_SA(0, 1), a2 + hstep, voffA);
            PG8_WAIT_L(8); PG8_BAR; PG8_WAIT_L(0); PG8_MMA(0, 0, At, B0); PG8_BAR; PG8_SCHED;
            PG8_LDB(B1, 1, 1); PG8_STAGE(PG8_SB(1, 0), b3, voffB);
            PG8_BAR; PG8_WAIT_L(0); PG8_MMA(0, 1, At, B1); PG8_BAR;
            PG8_LDA(At, 1, 1); PG8_STAGE(PG8_SA(1, 0), a3, voffA);
            PG8_BAR; PG8_WAIT_L(0); PG8_MMA(1, 0, At, B0); PG8_BAR; PG8_SCHED;
            PG8_STAGE(PG8_SB(1, 1), b3 + hstep, voffB);
            PG8_WAIT_V(6); PG8_BAR; PG8_MMA(1, 1, At, B1); PG8_BAR;
            }
        }
        if constexpr (ALIGN_EPI) { if (wr == 0) PG8_BAR; }
        if constexpr (!Epi::AFTER_DRAIN) { E(acc, cur, wr, wc, fr, fq); S.done(cur); }
        if (!has_next) break;
#pragma unroll
        for (int a = 0; a < 2; ++a)
#pragma unroll
            for (int b = 0; b < 2; ++b)
#pragma unroll
                for (int m = 0; m < 4; ++m)
#pragma unroll
                    for (int n = 0; n < 2; ++n) acc[a][b][m][n] = (f32x4){0.f, 0.f, 0.f, 0.f};
        cur = nxt; cA = nA; cB = nB; ++ui;
        if constexpr (ALIGN_EPI) { if (wr == 1) PG8_BAR; }
    }
    PG8_WAIT_V(0);
    if constexpr (!ALIGN_EPI) { if (wr == 0) PG8_BAR; }
    PG8_BAR;
    if constexpr (Epi::AFTER_DRAIN) { E.fused(acc, cur, wr, wc, fr, fq, lds, wid, lane); S.done(cur); }
#undef PG8_SA
#undef PG8_SB
#undef PG8_STAGE
#undef PG8_LDA
#undef PG8_LDB
#undef PG8_MMA
#undef PG8_WAIT_V
#undef PG8_WAIT_L
#undef PG8_BAR
#undef PG8_SCHED
}
}

using pg8::bf16_t;
#define LAS __attribute__((address_space(3)))
#define GAS __attribute__((address_space(1)))
typedef unsigned v4u __attribute__((ext_vector_type(4)));
typedef float f32x4 __attribute__((ext_vector_type(4)));
#define LDS_WAIT() asm volatile("s_waitcnt lgkmcnt(0)" ::: "memory")

__device__ __forceinline__ float bf2f(bf16_t u) { return __uint_as_float((unsigned)u << 16); }
__device__ __forceinline__ unsigned f2bf(float f) { unsigned u = __float_as_uint(f); return (u + 0x7fffu + ((u >> 16) & 1u)) >> 16; }
__device__ __forceinline__ unsigned pk2(float lo, float hi) { return f2bf(lo) | (f2bf(hi) << 16); }

__device__ __forceinline__ float wave_sum(float v) {
#pragma unroll
    for (int o = 1; o < 64; o <<= 1) v += __shfl_xor(v, o);
    return v;
}
__device__ __forceinline__ float wave_max(float v) {
#pragma unroll
    for (int o = 1; o < 64; o <<= 1) v = fmaxf(v, __shfl_xor(v, o));
    return v;
}
__device__ __forceinline__ float block_sum(float v, float* red, int tid) {
    v = wave_sum(v);
    __syncthreads();
    if ((tid & 63) == 0) red[tid >> 6] = v;
    __syncthreads();
    return red[0] + red[1] + red[2] + red[3];
}
__device__ __forceinline__ float block_max(float v, float* red, int tid) {
    v = wave_max(v);
    __syncthreads();
    if ((tid & 63) == 0) red[tid >> 6] = v;
    __syncthreads();
    return fmaxf(fmaxf(red[0], red[1]), fmaxf(red[2], red[3]));
}
__device__ __forceinline__ unsigned fkey(float f) {
    unsigned u = __float_as_uint(f);
    return (u & 0x80000000u) ? ~u : (u | 0x80000000u);
}

__device__ __forceinline__ void p0_transpose_item(const float* W, int K, int N, int k0, int n0, bf16_t* WT, int orow0, LAS float* scr, int lane) {
    const int ncol = n0 + (lane & 31);
#pragma unroll 8
    for (int i = 0; i < 32; ++i) { const int kk = 2 * i + (lane >> 5); scr[kk * 33 + (lane & 31)] = (ncol < N) ? W[(size_t)(k0 + kk) * N + ncol] : 0.f; }
    LDS_WAIT(); asm volatile("" ::: "memory");
    const int c = lane & 7;
#pragma unroll
    for (int j = 0; j < 4; ++j) { const int n = (lane >> 3) + 8 * j; const LAS float* sp = scr + (8 * c) * 33 + n;
        v4u o; o.x = pk2(sp[0 * 33], sp[1 * 33]); o.y = pk2(sp[2 * 33], sp[3 * 33]); o.z = pk2(sp[4 * 33], sp[5 * 33]); o.w = pk2(sp[6 * 33], sp[7 * 33]);
        *(GAS v4u*)(WT + (size_t)(orow0 + n) * K + k0 + 8 * c) = o; }
    LDS_WAIT(); asm volatile("" ::: "memory");
}
__device__ __forceinline__ void rms_row_to_bf16(const float* xrow, const float* g, bf16_t* orow, int lane) {
    const GAS f32x4* xr = (const GAS f32x4*)xrow + lane;
    const GAS f32x4* gr = (const GAS f32x4*)g + lane;
    f32x4 v[8]; float s = 0.f;
#pragma unroll
    for (int j = 0; j < 8; ++j) { v[j] = xr[64 * j]; s += (v[j].x * v[j].x + v[j].y * v[j].y) + (v[j].z * v[j].z + v[j].w * v[j].w); }
    const float rstd = rsqrtf(wave_sum(s) * (1.f / D) + EPS);
    GAS unsigned long long* o8 = (GAS unsigned long long*)orow + lane;
#pragma unroll
    for (int j = 0; j < 8; ++j) { const f32x4 gg = gr[64 * j];
        o8[64 * j] = (unsigned long long)pk2(v[j].x * rstd * gg.x, v[j].y * rstd * gg.y) | ((unsigned long long)pk2(v[j].z * rstd * gg.z, v[j].w * rstd * gg.w) << 32); }
}

__device__ __forceinline__ void nv_gemm_tile(bool active, int m0, int n0, int tid, float* sm, const float* A, int lda, const float* Bm, int ldb, float* C, int ldc,
                                             int N, int K, const float* R, int ldr) {
    float* As = sm;
    float* Bs = sm + 16 * 65;
    const int tx = tid & 15, ty = tid >> 4;
    float acc[4][4];
#pragma unroll
    for (int i = 0; i < 4; ++i)
#pragma unroll
        for (int j = 0; j < 4; ++j) acc[i][j] = 0.f;
    for (int k0 = 0; k0 < K; k0 += 16) {
        if (active) {
#pragma unroll
            for (int q = 0; q < 4; ++q) { int i = tid + 256 * q; int r = i >> 4, c = i & 15; As[c * 65 + r] = A[(size_t)(m0 + r) * lda + k0 + c]; }
#pragma unroll
            for (int q = 0; q < 4; ++q) { int i = tid + 256 * q; int r = i >> 6, c = i & 63; int n = n0 + c; Bs[r * 64 + c] = (n < N) ? Bm[(size_t)(k0 + r) * ldb + n] : 0.f; }
        }
        __syncthreads();
        if (active) {
#pragma unroll
            for (int kk = 0; kk < 16; ++kk) {
                float a[4], b[4];
#pragma unroll
                for (int i = 0; i < 4; ++i) a[i] = As[kk * 65 + ty * 4 + i];
#pragma unroll
                for (int j = 0; j < 4; ++j) b[j] = Bs[kk * 64 + tx * 4 + j];
#pragma unroll
                for (int i = 0; i < 4; ++i)
#pragma unroll
                    for (int j = 0; j < 4; ++j) acc[i][j] += a[i] * b[j];
            }
        }
        __syncthreads();
    }
    if (active) {
#pragma unroll
        for (int i = 0; i < 4; ++i)
#pragma unroll
            for (int j = 0; j < 4; ++j) {
                int m = m0 + ty * 4 + i, n = n0 + tx * 4 + j;
                if (n < N) { float v = acc[i][j]; if (R) v += R[(size_t)m * ldr + n]; C[(size_t)m * ldc + n] = v; }
            }
    }
}
__device__ __forceinline__ void nv_gemm_phase(int sub, int tid, float* sm, const float* A, int lda, const float* Bm, int ldb, float* C, int ldc,
                                              int M, int N, int K, const float* R, int ldr, const int* tile_e, size_t strideB) {
    const int ntn = (N + 63) / 64, ntm = M / 64, total = ntn * ntm;
    const int nsb = gridDim.x * 2, iters = (total + nsb - 1) / nsb;
    for (int it = 0; it < iters; ++it) {
        const int tile = (it * gridDim.x + blockIdx.x) * 2 + sub;
        bool active = tile < total;
        const int mt = active ? tile / ntn : 0, nt = active ? tile % ntn : 0;
        const float* Bp = Bm;
        if (tile_e && active) { const int e = tile_e[mt]; if (e < 0) active = false; else Bp = Bm + (size_t)e * strideB; }
        nv_gemm_tile(active, mt * 64, nt * 64, tid, sm, A, lda, Bp, ldb, C, ldc, N, K, R, ldr);
    }
}

__device__ __forceinline__ void nv_postproj(int t, int tid, bf16_t* pb, float* iwf, bf16_t* ikc, const float* qg, const float* kg, const float* lnw, const float* lnb, const float2* rot) {
    const int tl = t & (S - 1);
    bf16_t* p = pb + (size_t)t * LDP;
    const int w = tid >> 6, lane = tid & 63;
    for (int h = w; h < 8; h += 4) {
        bf16_t* q = p + OQ + h * 128; float a = bf2f(q[lane]), b = bf2f(q[lane + 64]);
        float ss = wave_sum(a * a + b * b); float r = rsqrtf(ss * (1.0f / 128) + EPS);
        q[lane] = (bf16_t)f2bf(a * r * qg[lane]); q[lane + 64] = (bf16_t)f2bf(b * r * qg[lane + 64]);
    }
    if (w < 2) {
        bf16_t* q = p + OKK + w * 128; float a = bf2f(q[lane]), b = bf2f(q[lane + 64]);
        float ss = wave_sum(a * a + b * b); float r = rsqrtf(ss * (1.0f / 128) + EPS);
        q[lane] = (bf16_t)f2bf(a * r * kg[lane]); q[lane + 64] = (bf16_t)f2bf(b * r * kg[lane + 64]);
    }
    if (w == 2) {
        float v = bf2f(p[OIK + lane]); float mean = wave_sum(v) * (1.0f / 64); float d = v - mean;
        float var = wave_sum(d * d) * (1.0f / 64);
        const bf16_t kb = (bf16_t)f2bf(d * rsqrtf(var + EPS) * lnw[lane] + lnb[lane]);
        p[OIK + lane] = kb; ikc[(size_t)t * 64 + lane] = kb;
    }
    if (w == 3 && lane < 16) iwf[t * 16 + lane] = bf2f(p[OIW + lane]) * 0.03125f;
    for (int it = w; it < 16; it += 4) {
        const int which = it >> 3, h = it & 7;
        bf16_t* r = p + (which ? ORK : ORQ) + h * 128;
        const float2 cs = rot[tl * 64 + lane];
        const float x1 = bf2f(r[lane]), x2 = bf2f(r[lane + 64]);
        const float sc = which ? 0.08838834764831845f : 1.f;
        r[lane] = (bf16_t)f2bf((x1 * cs.x - x2 * cs.y) * sc); r[lane + 64] = (bf16_t)f2bf((x1 * cs.y + x2 * cs.x) * sc);
    }
}

typedef short bf16x8_t __attribute__((ext_vector_type(8)));
typedef float f32x16_t __attribute__((ext_vector_type(16)));
__device__ __forceinline__ void idx_pair(int t0, const bf16_t* pb, const bf16_t* ikc, const float* iwf, unsigned long long* maskw, int lane) {
    const int r32 = lane & 31, hi = lane >> 5;
    const int tl0 = t0 & (S - 1), b0 = t0 - tl0, bidx = t0 / S;
    const int nvis = 64 * (tl0 / 64 + 1), ntile = nvis / 32;
    bf16x8_t af[4];
    { const bf16_t* ap = pb + (size_t)(t0 + (r32 >> 4)) * LDP + OIQ + (r32 & 15) * 64 + hi * 8;
#pragma unroll
      for (int ks = 0; ks < 4; ++ks) af[ks] = *(const bf16x8_t*)(ap + ks * 16); }
    float w0r[8], w1r[8];
#pragma unroll
    for (int r = 0; r < 8; ++r) { const int h = (r & 3) + 8 * (r >> 2) + 4 * hi; w0r[r] = iwf[(size_t)t0 * 16 + h]; w1r[r] = iwf[(size_t)(t0 + 1) * 16 + h]; }
    unsigned key[64];
#pragma unroll
    for (int j = 0; j < 64; ++j) key[j] = 0u;
    const bf16_t* kbase = ikc + (size_t)(b0 + r32) * 64 + hi * 8;
#pragma unroll
    for (int j = 0; j < 64; ++j) {
        if (j < ntile) {
            const bf16_t* kp = kbase + (size_t)j * 32 * 64;
            f32x16_t acc = {};
#pragma unroll
            for (int ks = 0; ks < 4; ++ks) { const bf16x8_t bfr = *(const bf16x8_t*)(kp + ks * 16); acc = __builtin_amdgcn_mfma_f32_32x32x16_bf16(af[ks], bfr, acc, 0, 0, 0); }
            float p0 = 0.f, p1 = 0.f;
#pragma unroll
            for (int r = 0; r < 8; ++r) { p0 += fmaxf(acc[r], 0.f) * w0r[r]; p1 += fmaxf(acc[8 + r], 0.f) * w1r[r]; }
            auto rr = __builtin_amdgcn_permlane32_swap(__float_as_uint(p0), __float_as_uint(p1), false, false);
            const float sc = __uint_as_float(rr[0]) + __uint_as_float(rr[1]);
            key[j] = fkey(sc);
        }
    }
    unsigned T = 1u;
    if (nvis > 256) {
        T = 0u; bool done = false;
        for (int bit = 31; bit >= 0; --bit) {
            const unsigned cand = T | (1u << bit);
            int c = 0;
#pragma unroll
            for (int j = 0; j < 64; ++j) if (j < ntile) c += (key[j] >= cand) ? 1 : 0;
#pragma unroll
            for (int o = 1; o < 32; o <<= 1) c += __shfl_xor(c, o);
            if (!done && c >= 256) T = cand;
            if (c == 256) done = true;
            if (__all(done)) break;
        }
    }
    unsigned w0lo = 0u, w0hi = 0u, w1lo = 0u, w1hi = 0u;
#pragma unroll
    for (int J = 0; J < 32; ++J) {
        const unsigned long long ma = __ballot(key[2 * J] >= T), mb = __ballot(key[2 * J + 1] >= T);
        if (lane == J) { w0lo = (unsigned)ma; w0hi = (unsigned)mb; w1lo = (unsigned)(ma >> 32); w1hi = (unsigned)(mb >> 32); }
    }
    if (lane < 32) {
        unsigned long long* mp = maskw + ((size_t)(bidx * 32 + lane)) * S + tl0;
        mp[0] = ((unsigned long long)w0hi << 32) | w0lo;
        mp[1] = ((unsigned long long)w1hi << 32) | w1lo;
    }
}

__device__ __forceinline__ void nv_attn(int t, int tid, float* sm, const bf16_t* pb, const unsigned long long* maskw, bf16_t* cat) {
    float* red = sm; float* sq = sm + 16; float* sc = sm + 16 + 512;
    const int tl = t & (S - 1), b0 = t - tl;
    const int nvis = 64 * (tl / 64 + 1);
    const bf16_t* p = pb + (size_t)t * LDP;
    for (int g = 0; g < 2; ++g) {
        __syncthreads();
        for (int i = tid; i < 512; i += 256) sq[i] = bf2f(p[OQ + g * 512 + i]);
        __syncthreads();
        for (int s = tid; s < nvis; s += 256) {
            const bool sel = (maskw[((size_t)((t / S) * 32 + (s >> 6))) * S + tl] >> (s & 63)) & 1ull;
            float d0 = -INFINITY, d1 = -INFINITY, d2 = -INFINITY, d3 = -INFINITY;
            if (sel) {
                const bf16_t* kp = pb + (size_t)(b0 + s) * LDP + OKK + g * 128;
                d0 = d1 = d2 = d3 = 0.f;
                for (int d = 0; d < 128; ++d) { const float kv = bf2f(kp[d]); d0 += sq[d] * kv; d1 += sq[128 + d] * kv; d2 += sq[256 + d] * kv; d3 += sq[384 + d] * kv; }
                const float scl = 0.08838834764831845f;
                d0 *= scl; d1 *= scl; d2 *= scl; d3 *= scl;
            }
            sc[s] = d0; sc[2048 + s] = d1; sc[4096 + s] = d2; sc[6144 + s] = d3;
        }
        __syncthreads();
        float inv[4];
#pragma unroll
        for (int hh = 0; hh < 4; ++hh) {
            float m = -INFINITY;
            for (int s = tid; s < nvis; s += 256) m = fmaxf(m, sc[hh * 2048 + s]);
            m = block_max(m, red, tid);
            float sum = 0.f;
            for (int s = tid; s < nvis; s += 256) { const float v = sc[hh * 2048 + s]; const float e = (v == -INFINITY) ? 0.f : expf(v - m); sc[hh * 2048 + s] = e; sum += e; }
            sum = block_sum(sum, red, tid);
            inv[hh] = 1.0f / sum;
        }
        __syncthreads();
        const int d = tid & 127, half = tid >> 7;
#pragma unroll
        for (int rep = 0; rep < 2; ++rep) {
            const int hh = half + 2 * rep;
            float acc = 0.f;
            for (int s = 0; s < nvis; ++s) {
                const float pe = sc[hh * 2048 + s];
                if (pe != 0.f) acc += pe * bf2f(pb[(size_t)(b0 + s) * LDP + OV + g * 128 + d]);
            }
            cat[(size_t)t * D + (g * 4 + hh) * 128 + d] = (bf16_t)f2bf(acc * (half == 0 ? (rep == 0 ? inv[0] : inv[2]) : (rep == 0 ? inv[1] : inv[3])));
        }
    }
}

__device__ __forceinline__ void nv_ret(int t, int tid, float* sm, const bf16_t* pb, const float* rng, bf16_t* cat) {
    float* red = sm; float* sq = sm + 16; float* comb = sm + 16 + 128; float* sw = sm + 16 + 128 + 256;
    const int tl = t & (S - 1), b0 = t - tl;
    const bf16_t* p = pb + (size_t)t * LDP;
    for (int h = 0; h < 8; ++h) {
        __syncthreads();
        if (tid < 128) sq[tid] = bf2f(p[ORQ + h * 128 + tid]);
        __syncthreads();
        const float lg = log1pf(-exp2f(-5.0f - (float)h));
        for (int m = tid; m <= tl; m += 256) {
            const bf16_t* kp = pb + (size_t)(b0 + m) * LDP + ORK + h * 128;
            float dot = 0.f;
            for (int d = 0; d < 128; ++d) dot += sq[d] * bf2f(kp[d]);
            sw[m] = dot * expf(lg * (float)(tl - m));
        }
        __syncthreads();
        const int e = tid & 127, half = tid >> 7;
        float acc = 0.f;
        for (int m = half; m <= tl; m += 2) acc += sw[m] * bf2f(pb[(size_t)(b0 + m) * LDP + ORV + h * 128 + e]);
        comb[tid] = acc;
        __syncthreads();
        float o = comb[e] + comb[e + 128];
        float ss = block_sum(half == 0 ? o * o : 0.f, red, tid);
        if (half == 0) {
            const float y = o * rsqrtf(ss * (1.0f / 128) + EPS) * rng[h * 128 + e];
            const float gt = bf2f(p[ORG + h * 128 + e]);
            cat[(size_t)t * D + 1024 + h * 128 + e] = (bf16_t)f2bf(gt / (1.0f + expf(-gt)) * y);
        }
    }
}

__device__ __forceinline__ void nv_router(int t, int tid, float* sm, const float* x1, const float* g2, const float* wg, const float* wr, bf16_t* h2, int* eid, float* ew, int* cnt) {
    float* red = sm; float* lg = sm + 16;
    float v[8], ss = 0.f;
#pragma unroll
    for (int j = 0; j < 8; ++j) { v[j] = x1[(size_t)t * D + tid + 256 * j]; ss += v[j] * v[j]; }
    ss = block_sum(ss, red, tid);
    const float r = rsqrtf(ss * (1.0f / D) + EPS);
#pragma unroll
    for (int j = 0; j < 8; ++j) { v[j] = v[j] * r * g2[tid + 256 * j]; h2[(size_t)t * D + tid + 256 * j] = (bf16_t)f2bf(v[j]); }
    for (int c = 0; c < 36; ++c) {
        float pa = 0.f;
#pragma unroll
        for (int j = 0; j < 8; ++j) {
            const int d = tid + 256 * j;
            const float w = (c < 4) ? wg[d * 4 + c] : wr[((size_t)((c - 4) >> 3) * D + d) * 8 + ((c - 4) & 7)];
            pa += v[j] * w;
        }
        pa = block_sum(pa, red, tid);
        if (tid == 0) lg[c] = pa;
    }
    __syncthreads();
    if (tid == 0) {
        int gs = 0; for (int c = 1; c < 4; ++c) if (lg[c] > lg[gs]) gs = c;
        float den = 0.f; for (int c = 0; c < 4; ++c) den += expf(lg[c] - lg[gs]);
        const float gate = 1.0f / den;
        const float* el = lg + 4 + gs * 8;
        int i0 = 0; for (int c = 1; c < 8; ++c) if (el[c] > el[i0]) i0 = c;
        int i1 = -1; for (int c = 0; c < 8; ++c) if (c != i0 && (i1 < 0 || el[c] > el[i1])) i1 = c;
        const float e1 = expf(el[i1] - el[i0]);
        const float w0 = 1.0f / (1.0f + e1) * gate, w1 = e1 / (1.0f + e1) * gate;
        eid[t * 2] = gs * 8 + i0; eid[t * 2 + 1] = gs * 8 + i1; ew[t * 2] = w0; ew[t * 2 + 1] = w1;
        atomicAdd(&cnt[gs * 8 + i0], 1); atomicAdd(&cnt[gs * 8 + i1], 1);
    }
}

__device__ __forceinline__ void nv_fill(int t, int tid, float* sm, const int* soff, const bf16_t* h2, const int* eid, const float* ew, int* fill, int* slot_of, float* slotw, bf16_t* xg) {
    int* sslot = (int*)sm;
    __syncthreads();
    if (tid < 2) {
        const int e = eid[t * 2 + tid];
        const int slot = soff[e] + atomicAdd(&fill[e], 1);
        sslot[tid] = slot; slot_of[t * 2 + tid] = slot; slotw[slot] = ew[t * 2 + tid];
    }
    __syncthreads();
    const v4u v = *(const v4u*)(h2 + (size_t)t * D + tid * 8);
    *(v4u*)(xg + (size_t)sslot[0] * D + tid * 8) = v;
    *(v4u*)(xg + (size_t)sslot[1] * D + tid * 8) = v;
}

namespace att {
using bf16x8 = __attribute__((ext_vector_type(8))) short;
using s16x4  = __attribute__((ext_vector_type(4))) short;
using f32x16 = __attribute__((ext_vector_type(16))) float;
using u32x4  = __attribute__((ext_vector_type(4))) unsigned;
constexpr int   D = 128, NW = 8, QBLK = 32, KVBLK = 64;
constexpr float SCALE = 0.088388347648318440f;
constexpr float THR = 8.f;
constexpr size_t SHM_V = KVBLK * D * 2, SHM_K = KVBLK * D * 2, SHM_ATTN = 2 * SHM_V + 2 * SHM_K + NW * 64 * 4;
#define KSWZ(row, colB) ((row) * 256 + ((colB) ^ (((row) & 7) << 4)))
#define SBAR() __builtin_amdgcn_sched_barrier(0)
__device__ __forceinline__ int crow(int r, int hi) { return (r & 3) + 8 * (r >> 2) + 4 * hi; }
__device__ __forceinline__ unsigned cvtpk(float lo, float hi) {
  unsigned r; asm volatile("v_cvt_pk_bf16_f32 %0, %1, %2" : "=v"(r) : "v"(lo), "v"(hi)); return r;
}
__device__ __forceinline__ void partialSM(f32x16& p0, f32x16& p1, float& m_reg, float& mn, float& alpha) {
  constexpr float C = SCALE * 1.4426950408889634f;
  float pmax = p0[0]; for (int r = 1; r < 16; ++r) pmax = fmaxf(pmax, p0[r]); for (int r = 0; r < 16; ++r) pmax = fmaxf(pmax, p1[r]);
  { auto rr = __builtin_amdgcn_permlane32_swap(__float_as_uint(pmax), __float_as_uint(pmax), false, false);
    pmax = fmaxf(__uint_as_float(rr[0]), __uint_as_float(rr[1])); }
  if (__builtin_expect(__all(pmax - m_reg <= THR / SCALE), 1)) { mn = m_reg; alpha = 1.f; }
  else { mn = fmaxf(m_reg, pmax); alpha = __builtin_amdgcn_exp2f((m_reg - mn) * C); m_reg = mn; }
  float mnC = -mn * C;
  for (int r = 0; r < 16; ++r) p0[r] = fmaf(p0[r], C, mnC); for (int r = 0; r < 16; ++r) p1[r] = fmaf(p1[r], C, mnC);
  for (int r = 0; r < 16; ++r) p0[r] = __builtin_amdgcn_exp2f(p0[r]);
}
__device__ __forceinline__ void finishSM(f32x16& p0, f32x16& p1, float alpha, float& l_reg, bf16x8& pa0, bf16x8& pa1, bf16x8& pa2, bf16x8& pa3) {
  for (int r = 0; r < 16; ++r) p1[r] = __builtin_amdgcn_exp2f(p1[r]);
  float ps = 0; for (int r = 0; r < 16; ++r) ps += p0[r]; for (int r = 0; r < 16; ++r) ps += p1[r];
  { auto rr = __builtin_amdgcn_permlane32_swap(__float_as_uint(ps), __float_as_uint(ps), false, false);
    ps = __uint_as_float(rr[0]) + __uint_as_float(rr[1]); }
  l_reg = l_reg * alpha + ps;
#define PK4(P, BASE, OUT) do { unsigned a0 = cvtpk(P[BASE + 0], P[BASE + 1]), a1 = cvtpk(P[BASE + 2], P[BASE + 3]);   \
    unsigned b0 = cvtpk(P[BASE + 4], P[BASE + 5]), b1 = cvtpk(P[BASE + 6], P[BASE + 7]);                              \
    auto r0 = __builtin_amdgcn_permlane32_swap(a0, b0, false, false); auto r1 = __builtin_amdgcn_permlane32_swap(a1, b1, false, false); \
    u32x4 w = {r0[0], r1[0], r0[1], r1[1]}; OUT = *reinterpret_cast<bf16x8*>(&w); } while (0)
  PK4(p0, 0, pa0); PK4(p0, 8, pa1); PK4(p1, 0, pa2); PK4(p1, 8, pa3);
#undef PK4
}
__device__ __forceinline__ void qkt(f32x16& p0, f32x16& p1, const bf16_t* Ks, const bf16x8* qr, int r32, int hi) {
  p0 = f32x16{}; p1 = f32x16{};
  for (int d0 = 0; d0 < 8; ++d0) { int cb = (d0 * 16 + hi * 8) * 2;
    bf16x8 b0 = *reinterpret_cast<const bf16x8*>((const char*)Ks + KSWZ(r32, cb));
    bf16x8 b1 = *reinterpret_cast<const bf16x8*>((const char*)Ks + KSWZ(32 + r32, cb));
    p0 = __builtin_amdgcn_mfma_f32_32x32x16_bf16(b0, qr[d0], p0, 0, 0, 0);
    p1 = __builtin_amdgcn_mfma_f32_32x32x16_bf16(b1, qr[d0], p1, 0, 0, 0); }
}
__device__ __forceinline__ int v_st(int k, int c) { const int kk = (k & ~0xC) | ((k & 4) << 1) | ((k & 8) >> 1); return ((kk >> 3) * 4 + (c >> 5)) * 512 + ((kk & 7) * 32 + (c & 31)) * 2; }
__device__ __forceinline__ int v_rd_base(int lane) { return ((lane & 3) << 3) | (((lane >> 2) & 3) << 6) | (((lane >> 4) & 1) << 5) | (((lane >> 5) & 1) << 8); }
constexpr int v_rd_off(int d0, int ks, int half) { return d0 * 512 + ks * 4096 + half * 2048; }
template <int OFF> __device__ __forceinline__ s16x4 tr_read(int vb) {
  s16x4 r; asm volatile("ds_read_b64_tr_b16 %0, %1 offset:%2" : "=&v"(r) : "v"(vb), "i"(OFF) : "memory"); return r;
}
template <int D0> __device__ __forceinline__ void pv_one(f32x16& od, int vb, bf16x8 pa0, bf16x8 pa1, bf16x8 pa2, bf16x8 pa3) {
  const s16x4 l0 = tr_read<v_rd_off(D0, 0, 0)>(vb), h0 = tr_read<v_rd_off(D0, 0, 1)>(vb), l1 = tr_read<v_rd_off(D0, 1, 0)>(vb), h1 = tr_read<v_rd_off(D0, 1, 1)>(vb);
  const s16x4 l2 = tr_read<v_rd_off(D0, 2, 0)>(vb), h2 = tr_read<v_rd_off(D0, 2, 1)>(vb), l3 = tr_read<v_rd_off(D0, 3, 0)>(vb), h3 = tr_read<v_rd_off(D0, 3, 1)>(vb);
  asm volatile("s_waitcnt lgkmcnt(0)" ::: "memory"); SBAR();
#define PK(L, H) (bf16x8){L[0], L[1], L[2], L[3], H[0], H[1], H[2], H[3]}
  od = __builtin_amdgcn_mfma_f32_32x32x16_bf16(pa0, PK(l0, h0), od, 0, 0, 0);
  od = __builtin_amdgcn_mfma_f32_32x32x16_bf16(pa1, PK(l1, h1), od, 0, 0, 0);
  od = __builtin_amdgcn_mfma_f32_32x32x16_bf16(pa2, PK(l2, h2), od, 0, 0, 0);
  od = __builtin_amdgcn_mfma_f32_32x32x16_bf16(pa3, PK(l3, h3), od, 0, 0, 0);
#undef PK
}
__device__ __forceinline__ void pv_d0(f32x16* o, int vb, bf16x8 pa0, bf16x8 pa1, bf16x8 pa2, bf16x8 pa3) {
  pv_one<0>(o[0], vb, pa0, pa1, pa2, pa3); pv_one<1>(o[1], vb, pa0, pa1, pa2, pa3); pv_one<2>(o[2], vb, pa0, pa1, pa2, pa3); pv_one<3>(o[3], vb, pa0, pa1, pa2, pa3);
}

__device__ __forceinline__ void apply_mask(f32x16& p0, f32x16& p1, unsigned lo, unsigned hi_) {
#pragma unroll
  for (int r = 0; r < 16; ++r) { const unsigned bit = 1u << ((r & 3) + 8 * (r >> 2));
    p0[r] = (lo & bit) ? p0[r] : -INFINITY; p1[r] = (hi_ & bit) ? p1[r] : -INFINITY; }
}
template <int LDQ, int LDK, int LDO, int MSTR>
__device__ __forceinline__ void att_unit(const bf16_t* __restrict__ Qb, const bf16_t* __restrict__ Kh, const bf16_t* __restrict__ Vh, bf16_t* __restrict__ Ob,
                                         const unsigned long long* __restrict__ mrow, int seq, char* lds) {
  const int tid = otid(), wid = tid >> 6, lane = tid & 63, r32 = lane & 31, hi = lane >> 5;
  bf16_t* V_lds = (bf16_t*)lds; bf16_t* K_lds = (bf16_t*)(lds + 2 * SHM_V);
  float* ws = (float*)(lds + 2 * SHM_V + 2 * SHM_K) + wid * 64; float* li_l = ws; float* al_l = ws + 32;
  float m_reg = -1e30f, l_reg = 0; f32x16 o[4] = {}; bf16x8 qr[8];
  const bf16_t* Qw = Qb + (long)(wid * QBLK + r32) * LDQ + hi * 8;
#pragma unroll
  for (int d0 = 0; d0 < 8; ++d0) qr[d0] = *reinterpret_cast<const bf16x8*>(Qw + d0 * 16);
  const unsigned long long* mq = mrow + wid * QBLK + r32;
  const int sr = tid >> 4, sc = (tid & 15) * 8, vst0 = v_st(sr, sc), vst1 = v_st(32 + sr, sc);
  const int vb0 = (int)(uintptr_t)V_lds + v_rd_base(lane);
  constexpr int SDEPTH = 1, SE = 0, SO = SDEPTH - 1;
  struct { bf16x8 vs0, vs1, ks0, ks1; } sr_[SDEPTH];
#define SLOAD(i, k0) do { sr_[i].vs0 = *reinterpret_cast<const bf16x8*>(&Vh[(long)((k0) + sr) * LDK + sc]); sr_[i].vs1 = *reinterpret_cast<const bf16x8*>(&Vh[(long)((k0) + 32 + sr) * LDK + sc]); \
    sr_[i].ks0 = *reinterpret_cast<const bf16x8*>(&Kh[(long)((k0) + sr) * LDK + sc]); sr_[i].ks1 = *reinterpret_cast<const bf16x8*>(&Kh[(long)((k0) + 32 + sr) * LDK + sc]); } while (0)
#define SWRITE(b, i) do { *(bf16x8*)((char*)V_lds + (b) * SHM_V + vst0) = sr_[i].vs0;          \
    *(bf16x8*)((char*)V_lds + (b) * SHM_V + vst1) = sr_[i].vs1; int kc = sc * 2;               \
    *(bf16x8*)((char*)K_lds + (b) * SHM_K + KSWZ(sr, kc)) = sr_[i].ks0;                       \
    *(bf16x8*)((char*)K_lds + (b) * SHM_K + KSWZ(32 + sr, kc)) = sr_[i].ks1; } while (0)
#define SWAIT() do { if constexpr (SDEPTH == 2) asm volatile("s_waitcnt vmcnt(4)" ::: "memory"); else asm volatile("s_waitcnt vmcnt(0)" ::: "memory"); } while (0)
#define RESC(a) do { if (__any((a) < 1.f)) { if (hi == 0) al_l[r32] = (a); asm volatile("s_waitcnt lgkmcnt(0)" ::: "memory"); \
    for (int d = 0; d < 4; ++d) for (int r = 0; r < 16; ++r) o[d][r] *= al_l[crow(r, hi)]; } } while (0)
#define MLOAD(j) (mq[(long)(j) * MSTR])
#define MASK(P0, P1, mw) apply_mask(P0, P1, (unsigned)(mw) >> (4 * hi), (unsigned)((mw) >> 32) >> (4 * hi))
  f32x16 p0, p1; float mn, al; bf16x8 pa0, pa1, pa2, pa3; const int NT = seq / KVBLK;
  unsigned long long mw;
  SLOAD(SE, 0); mw = MLOAD(0); asm volatile("s_waitcnt vmcnt(0)" ::: "memory"); SWRITE(0, SE); __syncthreads();
  for (int j = 0; j < NT; ++j) {
    const int cur = j & 1; const bool more = (j + 1 < NT);
    if (more) SLOAD(SE, (j + 1) * KVBLK);
    SBAR(); qkt(p0, p1, (bf16_t*)((char*)K_lds + cur * SHM_K), qr, r32, hi);
    MASK(p0, p1, mw); if (more) mw = MLOAD(j + 1);
    partialSM(p0, p1, m_reg, mn, al);
    RESC(al);
    finishSM(p0, p1, al, l_reg, pa0, pa1, pa2, pa3); SBAR();
    pv_d0(o, vb0 + cur * (int)SHM_V, pa0, pa1, pa2, pa3);
    if (more) { SWAIT(); SWRITE(cur ^ 1, SE); }
    __syncthreads();
  }
  if (hi == 0) li_l[r32] = l_reg; asm volatile("s_waitcnt lgkmcnt(0)" ::: "memory");
  float rli[16];
#pragma unroll
  for (int r = 0; r < 16; ++r) rli[r] = __builtin_amdgcn_rcpf(li_l[crow(r, hi)]);
  bf16_t* Ow = Ob + (long)(wid * QBLK) * LDO;
#pragma unroll
  for (int r = 0; r < 16; ++r) { const int orow = crow(r, hi);
#pragma unroll
    for (int d0 = 0; d0 < 4; ++d0) Ow[(long)orow * LDO + d0 * 32 + r32] = (bf16_t)f2bf(o[d0][r] * rli[r]); }
  __syncthreads();
#undef SLOAD
#undef SWRITE
#undef SWAIT
#undef RESC
#undef MLOAD
#undef MASK
}
#undef KSWZ
#undef SBAR
}

namespace ret {
using bf16x8 = __attribute__((ext_vector_type(8))) short;
using s16x4  = __attribute__((ext_vector_type(4))) short;
using f32x16 = __attribute__((ext_vector_type(16))) float;
using f32x4v = __attribute__((ext_vector_type(4))) float;
using u32x4  = __attribute__((ext_vector_type(4))) unsigned;
typedef short v4i16_t __attribute__((ext_vector_type(4)));
constexpr int PITCH = 272;
constexpr int IMG = 64 * PITCH;
__device__ __forceinline__ int crow(int r, int hi) { return (r & 3) + 8 * (r >> 2) + 4 * hi; }
__device__ __forceinline__ s16x4 vtr(const LAS char* p) { return __builtin_bit_cast(s16x4, __builtin_amdgcn_ds_read_tr16_b64_v4i16((LAS v4i16_t*)p)); }
__device__ __forceinline__ bf16x8 tr_frag(const LAS char* img, int r_lo, int r_hi, int cb, int lane) {
    const int i = lane & 15; const LAS char* a = img + (i >> 2) * PITCH + (cb + 4 * (i & 3)) * 2;
    const s16x4 lo = vtr(a + r_lo * PITCH), hi = vtr(a + r_hi * PITCH);
    return (bf16x8){lo[0], lo[1], lo[2], lo[3], hi[0], hi[1], hi[2], hi[3]};
}
__device__ __forceinline__ float l2gamma(int h) { return log1pf(-exp2f(-5.0f - (float)h)) * 1.4426950408889634f; }
template <bool SCALE>
__device__ __forceinline__ void stage_chunk(const bf16_t* src, LAS char* img, float l2g, int tid) {
#pragma unroll
    for (int i = 0; i < 2; ++i) {
        const int idx = tid * 2 + i, row = idx >> 4, c16 = idx & 15;
        u32x4 v = *(const u32x4*)(src + (size_t)row * LDP + c16 * 8);
        if (SCALE) {
            const float sd = exp2f((float)(63 - row) * l2g);
#pragma unroll
            for (int q = 0; q < 4; ++q) { const unsigned w = v[q]; v[q] = pk2(__uint_as_float(w << 16) * sd, __uint_as_float(w & 0xffff0000u) * sd); }
        }
        *(LAS u32x4*)(img + row * PITCH + c16 * 16) = v;
    }
}
__device__ __forceinline__ void r1_unit(int bh, int c, const bf16_t* projb, float* kvt, LAS char* lds) {
    const int tid = otid(), lane = tid & 63, wid = tid >> 6, r32 = lane & 31, hh = lane >> 5;
    const int b = bh >> 3, h = bh & 7; const size_t tok0 = (size_t)b * S + 64 * c;
    const float l2g = l2gamma(h);
    LAS char* kimg = lds; LAS char* vimg = lds + IMG;
    stage_chunk<true>(projb + tok0 * LDP + ORK + h * 128, kimg, l2g, tid);
    stage_chunk<false>(projb + tok0 * LDP + ORV + h * 128, vimg, l2g, tid);
    __syncthreads();
    const int eb = wid >> 1, db0 = (wid & 1) * 2, gcol = 16 * ((lane >> 4) & 1);
    f32x16 acc0 = {}, acc1 = {};
#pragma unroll
    for (int ks = 0; ks < 4; ++ks) {
        const int rl = 16 * ks + 8 * hh;
        const bf16x8 a = tr_frag(vimg, rl, rl + 4, 32 * eb + gcol, lane);
        const bf16x8 b0 = tr_frag(kimg, rl, rl + 4, 32 * db0 + gcol, lane);
        const bf16x8 b1 = tr_frag(kimg, rl, rl + 4, 32 * (db0 + 1) + gcol, lane);
        acc0 = __builtin_amdgcn_mfma_f32_32x32x16_bf16(a, b0, acc0, 0, 0, 0);
        acc1 = __builtin_amdgcn_mfma_f32_32x32x16_bf16(a, b1, acc1, 0, 0, 0);
    }
    float* o = kvt + ((size_t)(bh * 32 + c) * 128 + 32 * eb) * 128 + 32 * db0 + r32;
#pragma unroll
    for (int r = 0; r < 16; ++r) { o[(size_t)crow(r, hh) * 128] = acc0[r]; o[(size_t)crow(r, hh) * 128 + 32] = acc1[r]; }
    __syncthreads();
}
__device__ __forceinline__ void r2_scan(const float* kvt, bf16_t* rt, int G) {
    for (int g4 = blockIdx.x * NTHR + otid(); g4 < 32 * 4096; g4 += G * NTHR) {
        const int bh = g4 >> 12, idx = (g4 & 4095) * 4;
        const float cdk = exp2f(64.0f * l2gamma(bh & 7));
        f32x4v R = {0.f, 0.f, 0.f, 0.f};
        const float* kp = kvt + (size_t)bh * 32 * 16384 + idx; bf16_t* rp = rt + (size_t)bh * 32 * 16384 + idx;
#pragma unroll 4
        for (int c = 0; c < 32; ++c) {
            *(unsigned long long*)(rp + (size_t)c * 16384) = (unsigned long long)pk2(R[0], R[1]) | ((unsigned long long)pk2(R[2], R[3]) << 32);
            if (c < 31) { const f32x4v kv = *(const f32x4v*)(kp + (size_t)c * 16384); R = R * cdk + kv; }
        }
    }
}
__device__ __forceinline__ void r3_unit(int bh, int c, const bf16_t* projb, const bf16_t* rt, const float* rng, bf16_t* catb, LAS char* lds) {
    const int tid = otid(), lane = tid & 63, wid = tid >> 6, r32 = lane & 31, hh = lane >> 5;
    const int b = bh >> 3, h = bh & 7; const size_t tok0 = (size_t)b * S + 64 * c;
    const float l2g = l2gamma(h);
    LAS char* vimg = lds; LAS float* ssp = (LAS float*)(lds + IMG);
    stage_chunk<false>(projb + tok0 * LDP + ORV + h * 128, vimg, l2g, tid);
    const int nt = wid >> 2, eb = wid & 3, gcol = 16 * ((lane >> 4) & 1);
    bf16x8 qf[8];
    { const bf16_t* qp = projb + (tok0 + 32 * nt + r32) * LDP + ORQ + h * 128 + 8 * hh;
#pragma unroll
      for (int ks = 0; ks < 8; ++ks) qf[ks] = *(const bf16x8*)(qp + 16 * ks); }
    f32x16 o2 = {};
    { const bf16_t* rp = rt + ((size_t)(bh * 32 + c) * 128 + 32 * eb + r32) * 128 + 8 * hh;
#pragma unroll
      for (int ks = 0; ks < 8; ++ks) { const bf16x8 rf = *(const bf16x8*)(rp + 16 * ks); o2 = __builtin_amdgcn_mfma_f32_32x32x16_bf16(qf[ks], rf, o2, 0, 0, 0); } }
    __syncthreads();
    f32x16 o1 = {};
    const int n_lane = 32 * nt + r32;
#pragma unroll
    for (int mt = 0; mt < 2; ++mt) {
        if (mt <= nt) {
            f32x16 X = {};
            const bf16_t* kp = projb + (tok0 + 32 * mt + r32) * LDP + ORK + h * 128 + 8 * hh;
#pragma unroll
            for (int ks = 0; ks < 8; ++ks) { const bf16x8 kf = *(const bf16x8*)(kp + 16 * ks); X = __builtin_amdgcn_mfma_f32_32x32x16_bf16(kf, qf[ks], X, 0, 0, 0); }
#pragma unroll
            for (int r = 0; r < 16; ++r) { const int m = 32 * mt + crow(r, hh); X[r] = (n_lane >= m) ? X[r] * exp2f((float)(n_lane - m) * l2g) : 0.f; }
#pragma unroll
            for (int sidx = 0; sidx < 2; ++sidx) {
                u32x4 pw;
#pragma unroll
                for (int q = 0; q < 4; ++q) pw[q] = pk2(X[8 * sidx + 2 * q], X[8 * sidx + 2 * q + 1]);
                const int rl = 32 * mt + 16 * sidx + 4 * hh;
                const bf16x8 vf = tr_frag(vimg, rl, rl + 8, 32 * eb + gcol, lane);
                o1 = __builtin_amdgcn_mfma_f32_32x32x16_bf16(__builtin_bit_cast(bf16x8, pw), vf, o1, 0, 0, 0);
            }
        }
    }
    float o[16];
#pragma unroll
    for (int r = 0; r < 16; ++r) {
        const int n = 32 * nt + crow(r, hh);
        o[r] = o1[r] + o2[r] * exp2f((float)(n + 1) * l2g);
        float sq = o[r] * o[r];
#pragma unroll
        for (int off = 1; off < 32; off <<= 1) sq += __shfl_xor(sq, off);
        if (r32 == 0) ssp[eb * 64 + n] = sq;
    }
    __syncthreads();
    const int e = 32 * eb + r32; const float ge = rng[h * 128 + e];
#pragma unroll
    for (int r = 0; r < 16; ++r) {
        const int n = 32 * nt + crow(r, hh);
        const float tot = (ssp[n] + ssp[64 + n]) + (ssp[128 + n] + ssp[192 + n]);
        const float gt = bf2f(projb[(tok0 + n) * LDP + ORG + h * 128 + e]);
        const float y = o[r] * rsqrtf(tot * (1.0f / 128) + EPS) * ge * (gt / (1.0f + __expf(-gt)));
        catb[(tok0 + n) * D + 1024 + h * 128 + e] = (bf16_t)f2bf(y);
    }
    __syncthreads();
}
}

__global__ void __launch_bounds__(NTHR, 2) mega(Params P) {
    extern __shared__ __attribute__((aligned(16))) unsigned char lds[];
    cg::grid_group grid = cg::this_grid();
    int* soff = (int*)(lds + 2 * SUB_LDS);
    const int G = gridDim.x, nsb = G * 2, NGW = G * NWAVES;
#define PHASE_IDS() const int T_ = otid(); const int sub = T_ >> 8, tid = T_ & 255, lane = T_ & 63, wave = __builtin_amdgcn_readfirstlane(T_ >> 6); \
    float* sm = (float*)(lds + sub * SUB_LDS); const int sb = blockIdx.x * 2 + sub, gw = blockIdx.x * NWAVES + wave; (void)tid; (void)lane; (void)sm; (void)sb; (void)gw;
    char* ws = P.ws;
    int* cnt = (int*)(ws + WS_CTL); int* fill = cnt + 32; int* off = cnt + 64; int* tile_e = cnt + 256;
    int* eid = (int*)(ws + WS_EID); float* ew = (float*)(ws + WS_EW); int* slot_of = (int*)(ws + WS_SLOT); float* slotw = (float*)(ws + WS_SLOTW);
    float2* rot = (float2*)(ws + WS_ROT);
    bf16_t* projb = (bf16_t*)(ws + WS_PROJB); unsigned long long* maskw = (unsigned long long*)(ws + WS_MASK); bf16_t* ikc = (bf16_t*)(ws + WS_IKC); bf16_t* catb = (bf16_t*)(ws + WS_CATB);
    bf16_t* xgb = (bf16_t*)(ws + WS_PROJB); bf16_t* yb = xgb; bf16_t* hhb = (bf16_t*)(ws + WS_CATB);
    bf16_t* wint = (bf16_t*)(ws + WS_WINT); bf16_t* woutt = (bf16_t*)(ws + WS_WOUTT); bf16_t* w13t = (bf16_t*)(ws + WS_W13T); bf16_t* w2t = (bf16_t*)(ws + WS_W2T);
    bf16_t* xn = (bf16_t*)(ws + WS_XN); bf16_t* xn2 = xn; float* kvt = (float*)(ws + WS_KVT); bf16_t* rtb = (bf16_t*)(ws + WS_RT); float* iwf = (float*)(ws + WS_IWF);

    { PHASE_IDS();
    for (int idx = blockIdx.x * NTHR + T_; idx < 2048 * 64; idx += G * NTHR) {
        const int pos = idx >> 6, i = idx & 63;
        const double inv = exp(-log(10000.0) * (double)i / 63.0);
        const double ang = (double)pos * inv;
        rot[idx] = make_float2((float)cos(ang), (float)sin(ang));
    }
    {
        LAS float* scr = (LAS float*)((LAS unsigned char*)lds + wave * 16384);
        constexpr int I_IN = (D / 64) * (LDP / 32), I_OUT = (D / 64) * (D / 32), I_13 = NE * (D / 64) * (FF / 32), I_2 = NE * (FF / 64) * (D / 32);
        constexpr int NITEMS = I_IN + I_OUT + 2 * I_13 + I_2;
        for (int it = gw; it < NITEMS; it += NGW) {
            int r = it;
            if (r < I_IN) { const int nb = r % (LDP / 32), kb = r / (LDP / 32); p0_transpose_item(P.w_in, D, INW, 64 * kb, 32 * nb, wint, 32 * nb, scr, lane); continue; } r -= I_IN;
            if (r < I_OUT) { const int nb = r % (D / 32), kb = r / (D / 32); p0_transpose_item(P.w_out, D, D, 64 * kb, 32 * nb, woutt, 32 * nb, scr, lane); continue; } r -= I_OUT;
            if (r < 2 * I_13) {
                const int which = r / I_13; r -= which * I_13;
                const int e = r / ((D / 64) * (FF / 32)); r -= e * ((D / 64) * (FF / 32));
                const int nb = r % (FF / 32), kb = r / (FF / 32), n0 = 32 * nb;
                const float* W = (which ? P.w3 : P.w1) + (size_t)e * D * FF;
                p0_transpose_item(W, D, FF, 64 * kb, n0, w13t + (size_t)e * 1024 * D, (n0 >> 7) * 256 + which * 128 + (n0 & 127), scr, lane); continue; }
            r -= 2 * I_13;
            { const int e = r / ((FF / 64) * (D / 32)); r -= e * ((FF / 64) * (D / 32));
              const int nb = r % (D / 32), kb = r / (D / 32);
              p0_transpose_item(P.w2 + (size_t)e * FF * D, FF, D, 64 * kb, 32 * nb, w2t + (size_t)e * D * FF, 32 * nb, scr, lane); }
        }
        for (int m = gw; m < NT; m += NGW) rms_row_to_bf16(P.x + (size_t)m * D, P.norm1_g, xn + (size_t)m * D, lane);
    }
    }
    grid.sync();
    {
        pg8::Gemm g{xn, wint, NT, LDP, D}; pg8::StaticOrder SO; SO.init(NT, LDP, G, (int)blockIdx.x);
        pg8::EpiBf16 E{projb, LDP};
        pg8::gemm_phase<pg8::EpiBf16, pg8::StaticOrder, true, true>((LAS unsigned char*)lds, g, SO, E);
    }
    grid.sync();
    { PHASE_IDS(); for (int t = sb; t < NT; t += nsb) nv_postproj(t, tid, projb, iwf, ikc, P.q_norm_g, P.k_norm_g, P.ln_w, P.ln_b, rot); }
    grid.sync();
    { PHASE_IDS();
    for (int i = 0; i * G + (int)blockIdx.x < NT / 16; ++i) {
        const int L = i * G + (int)blockIdx.x;
        const int u = (L < 256) ? L : 256 + (L & 128) + (127 - (L & 127));
        idx_pair(u * 16 + wave * 2, projb, ikc, iwf, maskw, lane);
    }
    }
    __syncthreads();
    for (int u = blockIdx.x; u < 1024; u += G) { if ((u & 31) != 31) ret::r1_unit(u >> 5, u & 31, projb, kvt, (LAS char*)lds); }
    grid.sync();
    for (int u = blockIdx.x; u < 256; u += G) {
        const int bg = u & 7, k = u >> 3, bb = bg >> 1, g = bg & 1, h = g * 4 + (k & 3), qb = k >> 2;
        const size_t row0 = (size_t)bb * S;
        att::att_unit<LDP, LDP, D, S>(projb + (row0 + 256 * qb) * LDP + OQ + h * 128, projb + row0 * LDP + OKK + g * 128, projb + row0 * LDP + OV + g * 128,
                                      catb + (row0 + 256 * qb) * D + h * 128, maskw + (size_t)(bb * 32) * S + 256 * qb, 256 * (qb + 1), (char*)lds);
    }
    ret::r2_scan(kvt, rtb, G);
    grid.sync();
    for (int u = blockIdx.x; u < 1024; u += G) ret::r3_unit(u >> 5, u & 31, projb, rtb, P.ret_g, catb, (LAS char*)lds);
    grid.sync();
    {
        pg8::Gemm g{catb, woutt, NT, D, D}; pg8::StaticOrder SO; SO.init(NT, D, G, (int)blockIdx.x);
        pg8::EpiF32Res E{P.x, P.out, D};
        pg8::gemm_phase<pg8::EpiF32Res, pg8::StaticOrder, true, true>((LAS unsigned char*)lds, g, SO, E);
    }
    grid.sync();
    { PHASE_IDS(); for (int t = sb; t < NT; t += nsb) nv_router(t, tid, sm, P.out, P.norm2_g, P.w_group, P.w_router, xn2, eid, ew, cnt); }
    grid.sync();
    { PHASE_IDS();
    if (T_ == 0) {
        int o = 0;
        for (int e = 0; e < NE; ++e) {
            soff[e] = o; const int nt = (cnt[e] + 255) / 256;
            if (blockIdx.x == 0) { off[e] = o; for (int i = 0; i < nt; ++i) tile_e[o / 256 + i] = e; }
            o += nt * 256;
        }
        soff[NE] = o;
        if (blockIdx.x == 0) { off[NE] = o; for (int i = o / 256; i < MAXTILES; ++i) tile_e[i] = 0; }
    }
    __syncthreads();
    for (int t = sb; t < NT; t += nsb) nv_fill(t, tid, sm, soff, xn2, eid, ew, fill, slot_of, slotw, xgb);
    for (int e = blockIdx.x; e < NE; e += G) {
        const int r0 = soff[e] + cnt[e], r1 = soff[e + 1];
        for (int r = r0; r < r1; ++r) {
            if (T_ == 0) slotw[r] = 0.f;
            if (T_ < 256) *(v4u*)(xgb + (size_t)r * D + T_ * 8) = (v4u){0u, 0u, 0u, 0u};
        }
    }
    }
    grid.sync();
    const int mtiles = off[NE] / 256;
    {
        pg8::Gemm g{xgb, w13t, MAXROWS, 1024, D}; pg8::GroupedOrder SO{tile_e, mtiles, 4, G, (int)blockIdx.x, (size_t)1024 * D};
        pg8::EpiSwiglu E{hhb, FF, slotw};
        pg8::gemm_phase<pg8::EpiSwiglu, pg8::GroupedOrder, true, true>((LAS unsigned char*)lds, g, SO, E);
    }
    grid.sync();
    {
        pg8::Gemm g{hhb, w2t, MAXROWS, D, FF}; pg8::GroupedOrder SO{tile_e, mtiles, 8, G, (int)blockIdx.x, (size_t)D * FF};
        pg8::EpiBf16 E{yb, D};
        pg8::gemm_phase<pg8::EpiBf16, pg8::GroupedOrder, true, true>((LAS unsigned char*)lds, g, SO, E);
    }
    grid.sync();
    { PHASE_IDS();
    for (int t = sb; t < NT; t += nsb) {
        const int s0 = slot_of[t * 2], s1 = slot_of[t * 2 + 1];
        for (int d = tid; d < D; d += 256) P.out[(size_t)t * D + d] += bf2f(yb[(size_t)s0 * D + d]) + bf2f(yb[(size_t)s1 * D + d]);
    }
    }
}

extern "C" void kernel_launch(void* const* d_in, const int* in_sizes, int n_in, void* d_out, int out_size, void* d_ws, size_t ws_size, hipStream_t stream) {
    static int grid_blocks = 0;
    if (grid_blocks == 0) {
        if (n_in != 15 || in_sizes[0] != NT * D || out_size != NT * D || ws_size < WS_END) {
            fprintf(stderr, "kernel_launch: unexpected shapes n_in %d in0 %d out %d ws %zu\n", n_in, n_in > 0 ? in_sizes[0] : -1, out_size, ws_size);
            grid_blocks = -1; return;
        }
        int dev = 0, cus = 0, per_cu = 0;
        (void)hipGetDevice(&dev);
        (void)hipDeviceGetAttribute(&cus, hipDeviceAttributeMultiprocessorCount, dev);
        (void)hipFuncSetAttribute((const void*)mega, hipFuncAttributeMaxDynamicSharedMemorySize, LDS_BYTES);
        (void)hipOccupancyMaxActiveBlocksPerMultiprocessor(&per_cu, (const void*)mega, NTHR, LDS_BYTES);
        if (per_cu < 1) { fprintf(stderr, "kernel_launch: occupancy query says %d blocks/CU\n", per_cu); per_cu = 1; }
        if (per_cu > 1) per_cu = 1;
        grid_blocks = 1; while (grid_blocks * 2 <= cus * per_cu) grid_blocks *= 2;
        fprintf(stderr, "kernel_launch: grid %d (cus %d)\n", grid_blocks, cus);
    }
    if (grid_blocks < 0) return;
    (void)hipMemsetAsync((char*)d_ws + WS_CTL, 0, 1024, stream);
    Params p{};
    p.x = (const float*)d_in[0]; p.norm1_g = (const float*)d_in[1]; p.w_in = (const float*)d_in[2]; p.q_norm_g = (const float*)d_in[3];
    p.k_norm_g = (const float*)d_in[4]; p.ln_w = (const float*)d_in[5]; p.ln_b = (const float*)d_in[6]; p.ret_g = (const float*)d_in[7];
    p.w_out = (const float*)d_in[8]; p.norm2_g = (const float*)d_in[9]; p.w_group = (const float*)d_in[10]; p.w_router = (const float*)d_in[11];
    p.w1 = (const float*)d_in[12]; p.w3 = (const float*)d_in[13]; p.w2 = (const float*)d_in[14];
    p.out = (float*)d_out; p.ws = (char*)d_ws;
    void* args[] = {&p};
    hipError_t e = hipLaunchCooperativeKernel((const void*)mega, dim3(grid_blocks), dim3(NTHR), args, LDS_BYTES, stream);
    if (e != hipSuccess) fprintf(stderr, "cooperative launch failed: %s (grid %d)\n", hipGetErrorString(e), grid_blocks);
}
```

```cpp
#include <hip/hip_runtime.h>
#include <hip/hip_cooperative_groups.h>
#include <cstdint>
#include <cstdio>
namespace cg = cooperative_groups;
__device__ __forceinline__ int otid() { int t = threadIdx.x; asm volatile("" : "+v"(t)); return t; }

namespace cfg {
constexpr int B = 4, S = 2048, D = 2048, NT = B * S;
constexpr int INW = 6736, LDP = 6912;
constexpr int OQ = 0, OKK = 1024, OV = 1280, OIQ = 1536, OIK = 2560, OIW = 2624, ORQ = 2640, ORK = 3664, ORV = 4688, ORG = 5712;
constexpr int NE = 32, FF = 512;
constexpr float EPS = 1e-6f;
constexpr int MAXROWS = 16384 + 32 * 256;
constexpr int MAXTILES = MAXROWS / 256;
constexpr int NTHR = 512, NWAVES = 8;
constexpr int LDS_BYTES = 147456;
constexpr int SUB_LDS = 65536;
}
using namespace cfg;

constexpr size_t MiB = 1u << 20;
constexpr size_t WS_CTL = 0;
constexpr size_t WS_BAR = 16 * 1024;
constexpr size_t WS_EID = 128 * 1024;
constexpr size_t WS_EW = 192 * 1024;
constexpr size_t WS_SLOT = 256 * 1024;
constexpr size_t WS_SLOTW = 320 * 1024;
constexpr size_t WS_IWF = 448 * 1024;
constexpr size_t WS_ROT = 1 * MiB;
constexpr size_t WS_WINT = 2 * MiB;
constexpr size_t WS_WOUTT = 29 * MiB;
constexpr size_t WS_W13T = 37 * MiB;
constexpr size_t WS_W2T = 165 * MiB;
constexpr size_t WS_XN = 229 * MiB;
constexpr size_t WS_PROJB = 261 * MiB;
constexpr size_t WS_CATB = 369 * MiB;
constexpr size_t WS_MASK = 401 * MiB;
constexpr size_t WS_IKC = 403 * MiB;
constexpr size_t WS_KVT = 404 * MiB;
constexpr size_t WS_RT = WS_XN;
constexpr size_t WS_END = 468 * MiB;

struct Params {
    const float *x, *norm1_g, *w_in, *q_norm_g, *k_norm_g, *ln_w, *ln_b, *ret_g, *w_out, *norm2_g, *w_group, *w_router, *w1, *w3, *w2;
    float* out;
    char* ws;
};
namespace pg8 {
#define PG8_LAS __attribute__((address_space(3)))
typedef unsigned short bf16_t;
typedef short bf16x8 __attribute__((ext_vector_type(8)));
typedef float f32x4 __attribute__((ext_vector_type(4)));
typedef unsigned u32x4 __attribute__((ext_vector_type(4)));
constexpr int BM = 256, BK = 64, HALF = 128, HTB = HALF * BK * 2  , STAGE_BYTES = 8 * HTB, NXCD = 8, WGM = 8;

__host__ __device__ __forceinline__ int lds_byte(int r, int c) { const int st = (r >> 4) * 2 + (c >> 5), rr = r & 15, cc = c & 31, ob = rr * 64 + cc * 2; return st * 1024 + (ob ^ (((ob >> 9) & 1) << 5)); }
__host__ __device__ __forceinline__ void stage_rc(int b, int& R, int& C) { const int st = b / 1024, sb = b % 1024, swz = sb ^ (((sb >> 9) & 1) << 5); R = (st >> 1) * 16 + swz / 64; C = (st & 1) * 32 + (swz % 64) / 2; }
__host__ __device__ __forceinline__ int perm32(int rho) { const int n = rho >> 4, i = rho & 15; return 8 * (i >> 2) + 4 * n + (i & 3); }

struct Unit { int pm, pn; };
struct Gemm { const bf16_t* A; const bf16_t* Bt; int M, N, K; };

struct StaticOrder {
    int nM, nN, nwg, G, c;
    __host__ __device__ void init(int M, int N, int G_, int c_) { nM = M / BM; nN = N / BM; nwg = nM * nN; G = G_; c = c_; }
    __host__ __device__ bool next(int i, Unit& u) const {
        const long L = (long)i * G + c; if (L >= nwg) return false;
        int wgid = (int)L; { const int q = nwg / NXCD, r = nwg % NXCD, xcd = wgid % NXCD, off = wgid / NXCD; wgid = (xcd < r ? xcd * (q + 1) : r * (q + 1) + (xcd - r) * q) + off; }
        const int nig = WGM * nN, gid = wgid / nig, fm = gid * WGM, gsz = (nM - fm) < WGM ? (nM - fm) : WGM;
        u.pm = fm + ((wgid % nig) % gsz); u.pn = (wgid % nig) / gsz; return true;
    }
    __device__ __forceinline__ void a_ready(const Unit&) const {}
    __device__ __forceinline__ void done(const Unit&) const {}
    __device__ __forceinline__ const bf16_t* b_base(const Unit&, const bf16_t* Bt) const { return Bt; }
};
struct GroupedOrder {
    const int* tile_e; int ntiles, nN, G, c; size_t strideB;
    __device__ __forceinline__ bool next(int i, Unit& u) const { const long L = (long)i * G + c; if (L >= (long)ntiles * nN) return false; u.pm = (int)(L / nN); u.pn = (int)(L % nN); return true; }
    __device__ __forceinline__ void a_ready(const Unit&) const {}
    __device__ __forceinline__ void done(const Unit&) const {}
    __device__ __forceinline__ const bf16_t* b_base(const Unit& u, const bf16_t* Bt) const { return Bt + (size_t)tile_e[u.pm] * strideB; }
};


__device__ __forceinline__ unsigned cvt_pk_bf16(float lo, float hi) { unsigned r; asm volatile("v_cvt_pk_bf16_f32 %0, %1, %2" : "=v"(r) : "v"(lo), "v"(hi)); return r; }
struct EpiBf16 {
    static constexpr bool PERM = true, AFTER_DRAIN = false;
    bf16_t* O; int ldc;
    __device__ __forceinline__ void operator()(const f32x4 (&acc)[2][2][4][2], const Unit& u, int wr, int wc, int fr, int fq) const {
        const int row0 = u.pm * BM + wr * 64 + fr; const int col0 = u.pn * BM + wc * 32 + 8 * fq;
#pragma unroll
        for (int ai = 0; ai < 2; ++ai)
#pragma unroll
            for (int m = 0; m < 4; ++m) { bf16_t* rowp = O + (size_t)(row0 + ai * HALF + m * 16) * ldc + col0;
#pragma unroll
                for (int bj = 0; bj < 2; ++bj) { const f32x4 v0 = acc[ai][bj][m][0], v1 = acc[ai][bj][m][1];
                    u32x4 w; w.x = cvt_pk_bf16(v0[0], v0[1]); w.y = cvt_pk_bf16(v0[2], v0[3]); w.z = cvt_pk_bf16(v1[0], v1[1]); w.w = cvt_pk_bf16(v1[2], v1[3]);
                    *(u32x4*)(rowp + bj * HALF) = w; } }
    }
};
struct EpiF32Res {
    static constexpr bool PERM = false, AFTER_DRAIN = false;
    const float* base; float* out; int ldc;
    __device__ __forceinline__ void operator()(const f32x4 (&acc)[2][2][4][2], const Unit& u, int wr, int wc, int fr, int fq) const {
        const int col0 = u.pn * BM + wc * 32 + 4 * fq;
#pragma unroll
        for (int ai = 0; ai < 2; ++ai)
#pragma unroll
            for (int m = 0; m < 4; ++m) { const size_t off = (size_t)(u.pm * BM + ai * HALF + wr * 64 + m * 16 + fr) * ldc + col0;
#pragma unroll
                for (int bj = 0; bj < 2; ++bj)
#pragma unroll
                    for (int n = 0; n < 2; ++n) { const f32x4 bs = *(const f32x4*)(base + off + bj * HALF + n * 16); *(f32x4*)(out + off + bj * HALF + n * 16) = bs + acc[ai][bj][m][n]; } }
    }
};
struct EpiSwiglu {
    static constexpr bool PERM = true, AFTER_DRAIN = false;
    bf16_t* O; int ldc; const float* roww;
    __device__ __forceinline__ void operator()(const f32x4 (&acc)[2][2][4][2], const Unit& u, int wr, int wc, int fr, int fq) const {
        const int row0 = u.pm * BM + wr * 64 + fr; const int col0 = u.pn * HALF + wc * 32 + 8 * fq;
#pragma unroll
        for (int ai = 0; ai < 2; ++ai)
#pragma unroll
            for (int m = 0; m < 4; ++m) { const int row = row0 + ai * HALF + m * 16; const float w = roww[row];
                float h[8];
#pragma unroll
                for (int n = 0; n < 2; ++n)
#pragma unroll
                    for (int j = 0; j < 4; ++j) { const float a = acc[ai][0][m][n][j], b = acc[ai][1][m][n][j]; h[n * 4 + j] = a * __builtin_amdgcn_rcpf(1.0f + __expf(-a)) * b * w; }
                u32x4 o; o.x = cvt_pk_bf16(h[0], h[1]); o.y = cvt_pk_bf16(h[2], h[3]); o.z = cvt_pk_bf16(h[4], h[5]); o.w = cvt_pk_bf16(h[6], h[7]);
                *(u32x4*)(O + (size_t)row * ldc + col0) = o; }
    }
};

template <class Epi, class Sched, bool ALIGN_EPI = false, bool SP2 = false>
__device__ __forceinline__ void gemm_phase(PG8_LAS unsigned char* lds, const Gemm g, const Sched& S, const Epi& E) {
    const int tid = otid(), wid = __builtin_amdgcn_readfirstlane(tid >> 6), lane = tid & 63, wr = wid >> 2, wc = wid & 3, fr = lane & 15, fq = lane >> 4;
    const int K = g.K, nt = K / BK;
    unsigned voffA[2], voffB[2];
#pragma unroll
    for (int i = 0; i < 2; ++i) { int R, C; stage_rc(tid * 16 + i * 8192, R, C); const int Rb = Epi::PERM ? ((R & ~31) + perm32(R & 31)) : R;
        voffA[i] = (unsigned)(R * K + C) * 2u; voffB[i] = (unsigned)(Rb * K + C) * 2u; }
    const size_t kstep = (size_t)(BK * 2);
    const size_t hstep = (size_t)HALF * K * 2;
    const size_t tstep = 2 * hstep;
    const unsigned ldsw = (unsigned)wid * 1024u;
    const int aoff = lds_byte(wr * 64 + fr, fq * 8), boff = lds_byte(wc * 32 + fr, fq * 8);
#define PG8_SA(b, h) (((b) * 2 + (h)) * HTB)
#define PG8_SB(b, h) ((4 + (b) * 2 + (h)) * HTB)
#define PG8_STAGE(bufoff, gbase, voff) do { _Pragma("unroll") for (int _i = 0; _i < 2; ++_i) \
        __builtin_amdgcn_global_load_lds((const unsigned*)((const char*)(gbase) + (voff)[_i]), (PG8_LAS unsigned*)(lds + (bufoff) + ldsw + _i * 8192), 16, 0, 0); } while (0)
#define PG8_LDA(dst, b, h) do { _Pragma("unroll") for (int m = 0; m < 4; ++m) _Pragma("unroll") for (int k = 0; k < 2; ++k) dst[m][k] = *(const PG8_LAS bf16x8*)(lds + PG8_SA(b, h) + aoff + m * 2048 + k * 1024); } while (0)
#define PG8_LDB(dst, b, h) do { _Pragma("unroll") for (int n = 0; n < 2; ++n) _Pragma("unroll") for (int k = 0; k < 2; ++k) dst[n][k] = *(const PG8_LAS bf16x8*)(lds + PG8_SB(b, h) + boff + n * 2048 + k * 1024); } while (0)
#define PG8_MMA(ai, bj, At, Bt) do { __builtin_amdgcn_s_setprio(1); _Pragma("unroll") for (int m = 0; m < 4; ++m) _Pragma("unroll") for (int n = 0; n < 2; ++n) _Pragma("unroll") for (int k = 0; k < 2; ++k) \
        acc[ai][bj][m][n] = __builtin_amdgcn_mfma_f32_16x16x32_bf16(Bt[n][k], At[m][k], acc[ai][bj][m][n], 0, 0, 0); __builtin_amdgcn_s_setprio(0); } while (0)
#define PG8_WAIT_V(n) asm volatile("s_waitcnt vmcnt(" #n ")" ::: "memory")
#define PG8_WAIT_L(n) asm volatile("s_waitcnt lgkmcnt(" #n ")" ::: "memory")
#define PG8_BAR __builtin_amdgcn_s_barrier()
#define PG8_SCHED __builtin_amdgcn_sched_barrier(0)
    Unit cur, nxt; int ui = 0;
    if (!S.next(0, cur)) return;
    f32x4 acc[2][2][4][2];
#pragma unroll
    for (int a = 0; a < 2; ++a)
#pragma unroll
        for (int b = 0; b < 2; ++b)
#pragma unroll
            for (int m = 0; m < 4; ++m)
#pragma unroll
                for (int n = 0; n < 2; ++n) acc[a][b][m][n] = (f32x4){0.f, 0.f, 0.f, 0.f};
    bf16x8 At[4][2], B0[2][2], B1[2][2];
    const char* cA = (const char*)g.A + (size_t)cur.pm * tstep; const char* cB = (const char*)S.b_base(cur, g.Bt) + (size_t)cur.pn * tstep;
    S.a_ready(cur);
    if constexpr (SP2) {
        PG8_STAGE(PG8_SB(0, 0), cB, voffB); PG8_STAGE(PG8_SB(0, 1), cB + hstep, voffB); PG8_STAGE(PG8_SA(0, 0), cA, voffA); PG8_STAGE(PG8_SA(0, 1), cA + hstep, voffA);
        if (wr == 1) PG8_BAR;
        PG8_WAIT_V(2); PG8_BAR;
        PG8_STAGE(PG8_SB(1, 0), cB + kstep, voffB); PG8_STAGE(PG8_SA(1, 0), cA + kstep, voffA); PG8_STAGE(PG8_SB(1, 1), cB + hstep + kstep, voffB);
        PG8_WAIT_V(6); PG8_BAR;
    } else {
        PG8_STAGE(PG8_SB(0, 0), cB, voffB); PG8_STAGE(PG8_SA(0, 0), cA, voffA); PG8_STAGE(PG8_SB(0, 1), cB + hstep, voffB); PG8_STAGE(PG8_SA(0, 1), cA + hstep, voffA);
        if (wr == 1) PG8_BAR;
        PG8_WAIT_V(4); PG8_BAR;
        PG8_STAGE(PG8_SB(1, 0), cB + kstep, voffB); PG8_STAGE(PG8_SA(1, 0), cA + kstep, voffA); PG8_STAGE(PG8_SB(1, 1), cB + hstep + kstep, voffB);
        PG8_WAIT_V(6); PG8_BAR;
    }
    for (;;) {
        const bool has_next = S.next(ui + 1, nxt);
        const char* nA = has_next ? (const char*)g.A + (size_t)nxt.pm * tstep : cA; const char* nB = has_next ? (const char*)S.b_base(nxt, g.Bt) + (size_t)nxt.pn * tstep : cB;
        for (int t = 0; t < nt; t += 2) {
            const bool last = (t == nt - 2);
            const char* a1 = cA + (size_t)(t + 1) * kstep;
            const char* a2 = last ? nA : cA + (size_t)(t + 2) * kstep; const char* b2 = last ? nB : cB + (size_t)(t + 2) * kstep;
            const char* a3 = a2 + kstep; const char* b3 = b2 + kstep;
            if (last && has_next) S.a_ready(nxt);
            if constexpr (SP2) {
            PG8_LDB(B0, 0, 0); PG8_LDB(B1, 0, 1); PG8_SCHED; PG8_LDA(At, 0, 0); PG8_STAGE(PG8_SA(1, 1), a1 + hstep, voffA);
            PG8_WAIT_V(8); PG8_WAIT_L(0); PG8_BAR; PG8_MMA(0, 0, At, B0); PG8_MMA(0, 1, At, B1); PG8_BAR; PG8_SCHED;
            PG8_LDA(At, 0, 1); PG8_STAGE(PG8_SB(0, 0), b2, voffB); PG8_STAGE(PG8_SB(0, 1), b2 + hstep, voffB); PG8_STAGE(PG8_SA(0, 0), a2, voffA);
            PG8_WAIT_V(8); PG8_WAIT_L(0); PG8_BAR; PG8_MMA(1, 0, At, B0); PG8_MMA(1, 1, At, B1); PG8_BAR; PG8_SCHED;
            PG8_LDB(B0, 1, 0); PG8_LDB(B1, 1, 1); PG8_SCHED; PG8_LDA(At, 1, 0); PG8_STAGE(PG8_SA(0, 1), a2 + hstep, voffA);
            PG8_WAIT_V(8); PG8_WAIT_L(0); PG8_BAR; PG8_MMA(0, 0, At, B0); PG8_MMA(0, 1, At, B1); PG8_BAR; PG8_SCHED;
            PG8_LDA(At, 1, 1); PG8_STAGE(PG8_SB(1, 0), b3, voffB); PG8_STAGE(PG8_SB(1, 1), b3 + hstep, voffB); PG8_STAGE(PG8_SA(1, 0), a3, voffA);
            PG8_WAIT_V(8); PG8_WAIT_L(0); PG8_BAR; PG8_MMA(1, 0, At, B0); PG8_MMA(1, 1, At, B1); PG8_BAR; PG8_SCHED;
            } else {
            PG8_LDB(B0, 0, 0); PG8_SCHED; PG8_LDA(At, 0, 0); PG8_STAGE(PG8_SA(1, 1), a1 + hstep, voffA);
            PG8_WAIT_L(8); PG8_BAR; PG8_WAIT_L(0); PG8_MMA(0, 0, At, B0); PG8_BAR; PG8_SCHED;
            PG8_LDB(B1, 0, 1); PG8_STAGE(PG8_SB(0, 0), b2, voffB);
            PG8_BAR; PG8_WAIT_L(0); PG8_MMA(0, 1, At, B1); PG8_BAR;
            PG8_LDA(At, 0, 1); PG8_STAGE(PG8_SA(0, 0), a2, voffA);
            PG8_BAR; PG8_WAIT_L(0); PG8_MMA(1, 0, At, B0); PG8_BAR; PG8_SCHED;
            PG8_STAGE(PG8_SB(0, 1), b2 + hstep, voffB);
            PG8_WAIT_V(6); PG8_BAR; PG8_MMA(1, 1, At, B1); PG8_BAR;
            PG8_LDB(B0, 1, 0); PG8_SCHED; PG8_LDA(At, 1, 0); PG8_STAGE(PG8_SA(0, 1), a2 + hstep, voffA);
            PG8_WAIT_L(8); PG8_BAR; PG8_WAIT_L(0); PG8_MMA(0, 0, At, B0); PG8_BAR; PG8_SCHED;
            PG8_LDB(B1, 1, 1); PG8_STAGE(PG8_SB(1, 0), b3, voffB);
            PG8_BAR; PG8_WAIT_L(0); PG8_MMA(0, 1, At, B1); PG8_BAR;
            PG8_LDA(At, 1, 1); PG8_STAGE(PG8_SA(1, 0), a3, voffA);
            PG8_BAR; PG8_WAIT_L(0); PG8_MMA(1, 0, At, B0); PG8_BAR; PG8_SCHED;
            PG8_STAGE(PG8_SB(1, 1), b3 + hstep, voffB);
            PG8_WAIT_V(6); PG8_BAR; PG8_MMA(1, 1, At, B1); PG8_BAR;
            }
        }
        if constexpr (ALIGN_EPI) { if (wr == 0) PG8_BAR; }
        if constexpr (!Epi::AFTER_DRAIN) { E(acc, cur, wr, wc, fr, fq); S.done(cur); }
        if (!has_next) break;
#pragma unroll
        for (int a = 0; a < 2; ++a)
#pragma unroll
            for (int b = 0; b < 2; ++b)
#pragma unroll
                for (int m = 0; m < 4; ++m)
#pragma unroll
                    for (int n = 0; n < 2; ++n) acc[a][b][m][n] = (f32x4){0.f, 0.f, 0.f, 0.f};
        cur = nxt; cA = nA; cB = nB; ++ui;
        if constexpr (ALIGN_EPI) { if (wr == 1) PG8_BAR; }
    }
    PG8_WAIT_V(0);
    if constexpr (!ALIGN_EPI) { if (wr == 0) PG8_BAR; }
    PG8_BAR;
    if constexpr (Epi::AFTER_DRAIN) { E.fused(acc, cur, wr, wc, fr, fq, lds, wid, lane); S.done(cur); }
#undef PG8_SA
#undef PG8_SB
#undef PG8_STAGE
#undef PG8_LDA
#undef PG8_LDB
#undef PG8_MMA
#undef PG8_WAIT_V
#undef PG8_WAIT_L
#undef PG8_BAR
#undef PG8_SCHED
}
}

using pg8::bf16_t;
#define LAS __attribute__((address_space(3)))
#define GAS __attribute__((address_space(1)))
typedef unsigned v4u __attribute__((ext_vector_type(4)));
typedef float f32x4 __attribute__((ext_vector_type(4)));
#define LDS_WAIT() asm volatile("s_waitcnt lgkmcnt(0)" ::: "memory")

__device__ __forceinline__ float bf2f(bf16_t u) { return __uint_as_float((unsigned)u << 16); }
__device__ __forceinline__ unsigned f2bf(float f) { unsigned u = __float_as_uint(f); return (u + 0x7fffu + ((u >> 16) & 1u)) >> 16; }
__device__ __forceinline__ unsigned pk2(float lo, float hi) { return f2bf(lo) | (f2bf(hi) << 16); }

__device__ __forceinline__ float wave_sum(float v) {
#pragma unroll
    for (int o = 1; o < 64; o <<= 1) v += __shfl_xor(v, o);
    return v;
}
__device__ __forceinline__ float wave_max(float v) {
#pragma unroll
    for (int o = 1; o < 64; o <<= 1) v = fmaxf(v, __shfl_xor(v, o));
    return v;
}
__device__ __forceinline__ float block_sum(float v, float* red, int tid) {
    v = wave_sum(v);
    __syncthreads();
    if ((tid & 63) == 0) red[tid >> 6] = v;
    __syncthreads();
    return red[0] + red[1] + red[2] + red[3];
}
__device__ __forceinline__ float block_max(float v, float* red, int tid) {
    v = wave_max(v);
    __syncthreads();
    if ((tid & 63) == 0) red[tid >> 6] = v;
    __syncthreads();
    return fmaxf(fmaxf(red[0], red[1]), fmaxf(red[2], red[3]));
}
__device__ __forceinline__ unsigned fkey(float f) {
    unsigned u = __float_as_uint(f);
    return (u & 0x80000000u) ? ~u : (u | 0x80000000u);
}

__device__ __forceinline__ void p0_transpose_item(const float* W, int K, int N, int k0, int n0, bf16_t* WT, int orow0, LAS float* scr, int lane) {
    const int ncol = n0 + (lane & 31);
#pragma unroll 8
    for (int i = 0; i < 32; ++i) { const int kk = 2 * i + (lane >> 5); scr[kk * 33 + (lane & 31)] = (ncol < N) ? W[(size_t)(k0 + kk) * N + ncol] : 0.f; }
    LDS_WAIT(); asm volatile("" ::: "memory");
    const int c = lane & 7;
#pragma unroll
    for (int j = 0; j < 4; ++j) { const int n = (lane >> 3) + 8 * j; const LAS float* sp = scr + (8 * c) * 33 + n;
        v4u o; o.x = pk2(sp[0 * 33], sp[1 * 33]); o.y = pk2(sp[2 * 33], sp[3 * 33]); o.z = pk2(sp[4 * 33], sp[5 * 33]); o.w = pk2(sp[6 * 33], sp[7 * 33]);
        *(GAS v4u*)(WT + (size_t)(orow0 + n) * K + k0 + 8 * c) = o; }
    LDS_WAIT(); asm volatile("" ::: "memory");
}
__device__ __forceinline__ void rms_row_to_bf16(const float* xrow, const float* g, bf16_t* orow, int lane) {
    const GAS f32x4* xr = (const GAS f32x4*)xrow + lane;
    const GAS f32x4* gr = (const GAS f32x4*)g + lane;
    f32x4 v[8]; float s = 0.f;
#pragma unroll
    for (int j = 0; j < 8; ++j) { v[j] = xr[64 * j]; s += (v[j].x * v[j].x + v[j].y * v[j].y) + (v[j].z * v[j].z + v[j].w * v[j].w); }
    const float rstd = rsqrtf(wave_sum(s) * (1.f / D) + EPS);
    GAS unsigned long long* o8 = (GAS unsigned long long*)orow + lane;
#pragma unroll
    for (int j = 0; j < 8; ++j) { const f32x4 gg = gr[64 * j];
        o8[64 * j] = (unsigned long long)pk2(v[j].x * rstd * gg.x, v[j].y * rstd * gg.y) | ((unsigned long long)pk2(v[j].z * rstd * gg.z, v[j].w * rstd * gg.w) << 32); }
}

__device__ __forceinline__ void nv_gemm_tile(bool active, int m0, int n0, int tid, float* sm, const float* A, int lda, const float* Bm, int ldb, float* C, int ldc,
                                             int N, int K, const float* R, int ldr) {
    float* As = sm;
    float* Bs = sm + 16 * 65;
    const int tx = tid & 15, ty = tid >> 4;
    float acc[4][4];
#pragma unroll
    for (int i = 0; i < 4; ++i)
#pragma unroll
        for (int j = 0; j < 4; ++j) acc[i][j] = 0.f;
    for (int k0 = 0; k0 < K; k0 += 16) {
        if (active) {
#pragma unroll
            for (int q = 0; q < 4; ++q) { int i = tid + 256 * q; int r = i >> 4, c = i & 15; As[c * 65 + r] = A[(size_t)(m0 + r) * lda + k0 + c]; }
#pragma unroll
            for (int q = 0; q < 4; ++q) { int i = tid + 256 * q; int r = i >> 6, c = i & 63; int n = n0 + c; Bs[r * 64 + c] = (n < N) ? Bm[(size_t)(k0 + r) * ldb + n] : 0.f; }
        }
        __syncthreads();
        if (active) {
#pragma unroll
            for (int kk = 0; kk < 16; ++kk) {
                float a[4], b[4];
#pragma unroll
                for (int i = 0; i < 4; ++i) a[i] = As[kk * 65 + ty * 4 + i];
#pragma unroll
                for (int j = 0; j < 4; ++j) b[j] = Bs[kk * 64 + tx * 4 + j];
#pragma unroll
                for (int i = 0; i < 4; ++i)
#pragma unroll
                    for (int j = 0; j < 4; ++j) acc[i][j] += a[i] * b[j];
            }
        }
        __syncthreads();
    }
    if (active) {
#pragma unroll
        for (int i = 0; i < 4; ++i)
#pragma unroll
            for (int j = 0; j < 4; ++j) {
                int m = m0 + ty * 4 + i, n = n0 + tx * 4 + j;
                if (n < N) { float v = acc[i][j]; if (R) v += R[(size_t)m * ldr + n]; C[(size_t)m * ldc + n] = v; }
            }
    }
}
__device__ __forceinline__ void nv_gemm_phase(int sub, int tid, float* sm, const float* A, int lda, const float* Bm, int ldb, float* C, int ldc,
                                              int M, int N, int K, const float* R, int ldr, const int* tile_e, size_t strideB) {
    const int ntn = (N + 63) / 64, ntm = M / 64, total = ntn * ntm;
    const int nsb = gridDim.x * 2, iters = (total + nsb - 1) / nsb;
    for (int it = 0; it < iters; ++it) {
        const int tile = (it * gridDim.x + blockIdx.x) * 2 + sub;
        bool active = tile < total;
        const int mt = active ? tile / ntn : 0, nt = active ? tile % ntn : 0;
        const float* Bp = Bm;
        if (tile_e && active) { const int e = tile_e[mt]; if (e < 0) active = false; else Bp = Bm + (size_t)e * strideB; }
        nv_gemm_tile(active, mt * 64, nt * 64, tid, sm, A, lda, Bp, ldb, C, ldc, N, K, R, ldr);
    }
}

__device__ __forceinline__ void nv_postproj(int t, int tid, bf16_t* pb, float* iwf, bf16_t* ikc, const float* qg, const float* kg, const float* lnw, const float* lnb, const float2* rot) {
    const int tl = t & (S - 1);
    bf16_t* p = pb + (size_t)t * LDP;
    const int w = tid >> 6, lane = tid & 63;
    for (int h = w; h < 8; h += 4) {
        bf16_t* q = p + OQ + h * 128; float a = bf2f(q[lane]), b = bf2f(q[lane + 64]);
        float ss = wave_sum(a * a + b * b); float r = rsqrtf(ss * (1.0f / 128) + EPS);
        q[lane] = (bf16_t)f2bf(a * r * qg[lane]); q[lane + 64] = (bf16_t)f2bf(b * r * qg[lane + 64]);
    }
    if (w < 2) {
        bf16_t* q = p + OKK + w * 128; float a = bf2f(q[lane]), b = bf2f(q[lane + 64]);
        float ss = wave_sum(a * a + b * b); float r = rsqrtf(ss * (1.0f / 128) + EPS);
        q[lane] = (bf16_t)f2bf(a * r * kg[lane]); q[lane + 64] = (bf16_t)f2bf(b * r * kg[lane + 64]);
    }
    if (w == 2) {
        float v = bf2f(p[OIK + lane]); float mean = wave_sum(v) * (1.0f / 64); float d = v - mean;
        float var = wave_sum(d * d) * (1.0f / 64);
        const bf16_t kb = (bf16_t)f2bf(d * rsqrtf(var + EPS) * lnw[lane] + lnb[lane]);
        p[OIK + lane] = kb; ikc[(size_t)t * 64 + lane] = kb;
    }
    if (w == 3 && lane < 16) iwf[t * 16 + lane] = bf2f(p[OIW + lane]) * 0.03125f;
    for (int it = w; it < 16; it += 4) {
        const int which = it >> 3, h = it & 7;
        bf16_t* r = p + (which ? ORK : ORQ) + h * 128;
        const float2 cs = rot[tl * 64 + lane];
        const float x1 = bf2f(r[lane]), x2 = bf2f(r[lane + 64]);
        const float sc = which ? 0.08838834764831845f : 1.f;
        r[lane] = (bf16_t)f2bf((x1 * cs.x - x2 * cs.y) * sc); r[lane + 64] = (bf16_t)f2bf((x1 * cs.y + x2 * cs.x) * sc);
    }
}

typedef short bf16x8_t __attribute__((ext_vector_type(8)));
typedef float f32x16_t __attribute__((ext_vector_type(16)));
__device__ __forceinline__ void idx_pair(int t0, const bf16_t* pb, const bf16_t* ikc, const float* iwf, unsigned long long* maskw, int lane) {
    const int r32 = lane & 31, hi = lane >> 5;
    const int tl0 = t0 & (S - 1), b0 = t0 - tl0, bidx = t0 / S;
    const int nvis = 64 * (tl0 / 64 + 1), ntile = nvis / 32;
    bf16x8_t af[4];
    { const bf16_t* ap = pb + (size_t)(t0 + (r32 >> 4)) * LDP + OIQ + (r32 & 15) * 64 + hi * 8;
#pragma unroll
      for (int ks = 0; ks < 4; ++ks) af[ks] = *(const bf16x8_t*)(ap + ks * 16); }
    float w0r[8], w1r[8];
#pragma unroll
    for (int r = 0; r < 8; ++r) { const int h = (r & 3) + 8 * (r >> 2) + 4 * hi; w0r[r] = iwf[(size_t)t0 * 16 + h]; w1r[r] = iwf[(size_t)(t0 + 1) * 16 + h]; }
    unsigned key[64];
#pragma unroll
    for (int j = 0; j < 64; ++j) key[j] = 0u;
    const bf16_t* kbase = ikc + (size_t)(b0 + r32) * 64 + hi * 8;
#pragma unroll
    for (int j = 0; j < 64; ++j) {
        if (j < ntile) {
            const bf16_t* kp = kbase + (size_t)j * 32 * 64;
            f32x16_t acc = {};
#pragma unroll
            for (int ks = 0; ks < 4; ++ks) { const bf16x8_t bfr = *(const bf16x8_t*)(kp + ks * 16); acc = __builtin_amdgcn_mfma_f32_32x32x16_bf16(af[ks], bfr, acc, 0, 0, 0); }
            float p0 = 0.f, p1 = 0.f;
#pragma unroll
            for (int r = 0; r < 8; ++r) { p0 += fmaxf(acc[r], 0.f) * w0r[r]; p1 += fmaxf(acc[8 + r], 0.f) * w1r[r]; }
            auto rr = __builtin_amdgcn_permlane32_swap(__float_as_uint(p0), __float_as_uint(p1), false, false);
            const float sc = __uint_as_float(rr[0]) + __uint_as_float(rr[1]);
            key[j] = fkey(sc);
        }
    }
    unsigned T = 1u;
    if (nvis > 256) {
        T = 0u; bool done = false;
        for (int bit = 31; bit >= 0; --bit) {
            const unsigned cand = T | (1u << bit);
            int c = 0;
#pragma unroll
            for (int j = 0; j < 64; ++j) if (j < ntile) c += (key[j] >= cand) ? 1 : 0;
#pragma unroll
            for (int o = 1; o < 32; o <<= 1) c += __shfl_xor(c, o);
            if (!done && c >= 256) T = cand;
            if (c == 256) done = true;
            if (__all(done)) break;
        }
    }
    unsigned w0lo = 0u, w0hi = 0u, w1lo = 0u, w1hi = 0u;
#pragma unroll
    for (int J = 0; J < 32; ++J) {
        const unsigned long long ma = __ballot(key[2 * J] >= T), mb = __ballot(key[2 * J + 1] >= T);
        if (lane == J) { w0lo = (unsigned)ma; w0hi = (unsigned)mb; w1lo = (unsigned)(ma >> 32); w1hi = (unsigned)(mb >> 32); }
    }
    if (lane < 32) {
        unsigned long long* mp = maskw + ((size_t)(bidx * 32 + lane)) * S + tl0;
        mp[0] = ((unsigned long long)w0hi << 32) | w0lo;
        mp[1] = ((unsigned long long)w1hi << 32) | w1lo;
    }
}

__device__ __forceinline__ void nv_attn(int t, int tid, float* sm, const bf16_t* pb, const unsigned long long* maskw, bf16_t* cat) {
    float* red = sm; float* sq = sm + 16; float* sc = sm + 16 + 512;
    const int tl = t & (S - 1), b0 = t - tl;
    const int nvis = 64 * (tl / 64 + 1);
    const bf16_t* p = pb + (size_t)t * LDP;
    for (int g = 0; g < 2; ++g) {
        __syncthreads();
        for (int i = tid; i < 512; i += 256) sq[i] = bf2f(p[OQ + g * 512 + i]);
        __syncthreads();
        for (int s = tid; s < nvis; s += 256) {
            const bool sel = (maskw[((size_t)((t / S) * 32 + (s >> 6))) * S + tl] >> (s & 63)) & 1ull;
            float d0 = -INFINITY, d1 = -INFINITY, d2 = -INFINITY, d3 = -INFINITY;
            if (sel) {
                const bf16_t* kp = pb + (size_t)(b0 + s) * LDP + OKK + g * 128;
                d0 = d1 = d2 = d3 = 0.f;
                for (int d = 0; d < 128; ++d) { const float kv = bf2f(kp[d]); d0 += sq[d] * kv; d1 += sq[128 + d] * kv; d2 += sq[256 + d] * kv; d3 += sq[384 + d] * kv; }
                const float scl = 0.08838834764831845f;
                d0 *= scl; d1 *= scl; d2 *= scl; d3 *= scl;
            }
            sc[s] = d0; sc[2048 + s] = d1; sc[4096 + s] = d2; sc[6144 + s] = d3;
        }
        __syncthreads();
        float inv[4];
#pragma unroll
        for (int hh = 0; hh < 4; ++hh) {
            float m = -INFINITY;
            for (int s = tid; s < nvis; s += 256) m = fmaxf(m, sc[hh * 2048 + s]);
            m = block_max(m, red, tid);
            float sum = 0.f;
            for (int s = tid; s < nvis; s += 256) { const float v = sc[hh * 2048 + s]; const float e = (v == -INFINITY) ? 0.f : expf(v - m); sc[hh * 2048 + s] = e; sum += e; }
            sum = block_sum(sum, red, tid);
            inv[hh] = 1.0f / sum;
        }
        __syncthreads();
        const int d = tid & 127, half = tid >> 7;
#pragma unroll
        for (int rep = 0; rep < 2; ++rep) {
            const int hh = half + 2 * rep;
            float acc = 0.f;
            for (int s = 0; s < nvis; ++s) {
                const float pe = sc[hh * 2048 + s];
                if (pe != 0.f) acc += pe * bf2f(pb[(size_t)(b0 + s) * LDP + OV + g * 128 + d]);
            }
            cat[(size_t)t * D + (g * 4 + hh) * 128 + d] = (bf16_t)f2bf(acc * (half == 0 ? (rep == 0 ? inv[0] : inv[2]) : (rep == 0 ? inv[1] : inv[3])));
        }
    }
}

__device__ __forceinline__ void nv_ret(int t, int tid, float* sm, const bf16_t* pb, const float* rng, bf16_t* cat) {
    float* red = sm; float* sq = sm + 16; float* comb = sm + 16 + 128; float* sw = sm + 16 + 128 + 256;
    const int tl = t & (S - 1), b0 = t - tl;
    const bf16_t* p = pb + (size_t)t * LDP;
    for (int h = 0; h < 8; ++h) {
        __syncthreads();
        if (tid < 128) sq[tid] = bf2f(p[ORQ + h * 128 + tid]);
        __syncthreads();
        const float lg = log1pf(-exp2f(-5.0f - (float)h));
        for (int m = tid; m <= tl; m += 256) {
            const bf16_t* kp = pb + (size_t)(b0 + m) * LDP + ORK + h * 128;
            float dot = 0.f;
            for (int d = 0; d < 128; ++d) dot += sq[d] * bf2f(kp[d]);
            sw[m] = dot * expf(lg * (float)(tl - m));
        }
        __syncthreads();
        const int e = tid & 127, half = tid >> 7;
        float acc = 0.f;
        for (int m = half; m <= tl; m += 2) acc += sw[m] * bf2f(pb[(size_t)(b0 + m) * LDP + ORV + h * 128 + e]);
        comb[tid] = acc;
        __syncthreads();
        float o = comb[e] + comb[e + 128];
        float ss = block_sum(half == 0 ? o * o : 0.f, red, tid);
        if (half == 0) {
            const float y = o * rsqrtf(ss * (1.0f / 128) + EPS) * rng[h * 128 + e];
            const float gt = bf2f(p[ORG + h * 128 + e]);
            cat[(size_t)t * D + 1024 + h * 128 + e] = (bf16_t)f2bf(gt / (1.0f + expf(-gt)) * y);
        }
    }
}

__device__ __forceinline__ void nv_router(int t, int tid, float* sm, const float* x1, const float* g2, const float* wg, const float* wr, bf16_t* h2, int* eid, float* ew, int* cnt) {
    float* red = sm; float* lg = sm + 16;
    float v[8], ss = 0.f;
#pragma unroll
    for (int j = 0; j < 8; ++j) { v[j] = x1[(size_t)t * D + tid + 256 * j]; ss += v[j] * v[j]; }
    ss = block_sum(ss, red, tid);
    const float r = rsqrtf(ss * (1.0f / D) + EPS);
#pragma unroll
    for (int j = 0; j < 8; ++j) { v[j] = v[j] * r * g2[tid + 256 * j]; h2[(size_t)t * D + tid + 256 * j] = (bf16_t)f2bf(v[j]); }
    for (int c = 0; c < 36; ++c) {
        float pa = 0.f;
#pragma unroll
        for (int j = 0; j < 8; ++j) {
            const int d = tid + 256 * j;
            const float w = (c < 4) ? wg[d * 4 + c] : wr[((size_t)((c - 4) >> 3) * D + d) * 8 + ((c - 4) & 7)];
            pa += v[j] * w;
        }
        pa = block_sum(pa, red, tid);
        if (tid == 0) lg[c] = pa;
    }
    __syncthreads();
    if (tid == 0) {
        int gs = 0; for (int c = 1; c < 4; ++c) if (lg[c] > lg[gs]) gs = c;
        float den = 0.f; for (int c = 0; c < 4; ++c) den += expf(lg[c] - lg[gs]);
        const float gate = 1.0f / den;
        const float* el = lg + 4 + gs * 8;
        int i0 = 0; for (int c = 1; c < 8; ++c) if (el[c] > el[i0]) i0 = c;
        int i1 = -1; for (int c = 0; c < 8; ++c) if (c != i0 && (i1 < 0 || el[c] > el[i1])) i1 = c;
        const float e1 = expf(el[i1] - el[i0]);
        const float w0 = 1.0f / (1.0f + e1) * gate, w1 = e1 / (1.0f + e1) * gate;
        eid[t * 2] = gs * 8 + i0; eid[t * 2 + 1] = gs * 8 + i1; ew[t * 2] = w0; ew[t * 2 + 1] = w1;
        atomicAdd(&cnt[gs * 8 + i0], 1); atomicAdd(&cnt[gs * 8 + i1], 1);
    }
}

__device__ __forceinline__ void nv_fill(int t, int tid, float* sm, const int* soff, const bf16_t* h2, const int* eid, const float* ew, int* fill, int* slot_of, float* slotw, bf16_t* xg) {
    int* sslot = (int*)sm;
    __syncthreads();
    if (tid < 2) {
        const int e = eid[t * 2 + tid];
        const int slot = soff[e] + atomicAdd(&fill[e], 1);
        sslot[tid] = slot; slot_of[t * 2 + tid] = slot; slotw[slot] = ew[t * 2 + tid];
    }
    __syncthreads();
    const v4u v = *(const v4u*)(h2 + (size_t)t * D + tid * 8);
    *(v4u*)(xg + (size_t)sslot[0] * D + tid * 8) = v;
    *(v4u*)(xg + (size_t)sslot[1] * D + tid * 8) = v;
}

namespace att {
using bf16x8 = __attribute__((ext_vector_type(8))) short;
using s16x4  = __attribute__((ext_vector_type(4))) short;
using f32x16 = __attribute__((ext_vector_type(16))) float;
using u32x4  = __attribute__((ext_vector_type(4))) unsigned;
constexpr int   D = 128, NW = 8, QBLK = 32, KVBLK = 64;
constexpr float SCALE = 0.088388347648318440f;
constexpr float THR = 8.f;
constexpr size_t SHM_V = KVBLK * D * 2, SHM_K = KVBLK * D * 2, SHM_ATTN = 2 * SHM_V + 2 * SHM_K + NW * 64 * 4;
#define KSWZ(row, colB) ((row) * 256 + ((colB) ^ (((row) & 7) << 4)))
#define SBAR() __builtin_amdgcn_sched_barrier(0)
__device__ __forceinline__ int crow(int r, int hi) { return (r & 3) + 8 * (r >> 2) + 4 * hi; }
__device__ __forceinline__ unsigned cvtpk(float lo, float hi) {
  unsigned r; asm volatile("v_cvt_pk_bf16_f32 %0, %1, %2" : "=v"(r) : "v"(lo), "v"(hi)); return r;
}
__device__ __forceinline__ void partialSM(f32x16& p0, f32x16& p1, float& m_reg, float& mn, float& alpha) {
  constexpr float C = SCALE * 1.4426950408889634f;
  float pmax = p0[0]; for (int r = 1; r < 16; ++r) pmax = fmaxf(pmax, p0[r]); for (int r = 0; r < 16; ++r) pmax = fmaxf(pmax, p1[r]);
  { auto rr = __builtin_amdgcn_permlane32_swap(__float_as_uint(pmax), __float_as_uint(pmax), false, false);
    pmax = fmaxf(__uint_as_float(rr[0]), __uint_as_float(rr[1])); }
  if (__builtin_expect(__all(pmax - m_reg <= THR / SCALE), 1)) { mn = m_reg; alpha = 1.f; }
  else { mn = fmaxf(m_reg, pmax); alpha = __builtin_amdgcn_exp2f((m_reg - mn) * C); m_reg = mn; }
  float mnC = -mn * C;
  for (int r = 0; r < 16; ++r) p0[r] = fmaf(p0[r], C, mnC); for (int r = 0; r < 16; ++r) p1[r] = fmaf(p1[r], C, mnC);
  for (int r = 0; r < 16; ++r) p0[r] = __builtin_amdgcn_exp2f(p0[r]);
}
__device__ __forceinline__ void finishSM(f32x16& p0, f32x16& p1, float alpha, float& l_reg, bf16x8& pa0, bf16x8& pa1, bf16x8& pa2, bf16x8& pa3) {
  for (int r = 0; r < 16; ++r) p1[r] = __builtin_amdgcn_exp2f(p1[r]);
  float ps = 0; for (int r = 0; r < 16; ++r) ps += p0[r]; for (int r = 0; r < 16; ++r) ps += p1[r];
  { auto rr = __builtin_amdgcn_permlane32_swap(__float_as_uint(ps), __float_as_uint(ps), false, false);
    ps = __uint_as_float(rr[0]) + __uint_as_float(rr[1]); }
  l_reg = l_reg * alpha + ps;
#define PK4(P, BASE, OUT) do { unsigned a0 = cvtpk(P[BASE + 0], P[BASE + 1]), a1 = cvtpk(P[BASE + 2], P[BASE + 3]);   \
    unsigned b0 = cvtpk(P[BASE + 4], P[BASE + 5]), b1 = cvtpk(P[BASE + 6], P[BASE + 7]);                              \
    auto r0 = __builtin_amdgcn_permlane32_swap(a0, b0, false, false); auto r1 = __builtin_amdgcn_permlane32_swap(a1, b1, false, false); \
    u32x4 w = {r0[0], r1[0], r0[1], r1[1]}; OUT = *reinterpret_cast<bf16x8*>(&w); } while (0)
  PK4(p0, 0, pa0); PK4(p0, 8, pa1); PK4(p1, 0, pa2); PK4(p1, 8, pa3);
#undef PK4
}
__device__ __forceinline__ void qkt(f32x16& p0, f32x16& p1, const bf16_t* Ks, const bf16x8* qr, int r32, int hi) {
  p0 = f32x16{}; p1 = f32x16{};
  for (int d0 = 0; d0 < 8; ++d0) { int cb = (d0 * 16 + hi * 8) * 2;
    bf16x8 b0 = *reinterpret_cast<const bf16x8*>((const char*)Ks + KSWZ(r32, cb));
    bf16x8 b1 = *reinterpret_cast<const bf16x8*>((const char*)Ks + KSWZ(32 + r32, cb));
    p0 = __builtin_amdgcn_mfma_f32_32x32x16_bf16(b0, qr[d0], p0, 0, 0, 0);
    p1 = __builtin_amdgcn_mfma_f32_32x32x16_bf16(b1, qr[d0], p1, 0, 0, 0); }
}
__device__ __forceinline__ int v_st(int k, int c) { const int kk = (k & ~0xC) | ((k & 4) << 1) | ((k & 8) >> 1); return ((kk >> 3) * 4 + (c >> 5)) * 512 + ((kk & 7) * 32 + (c & 31)) * 2; }
__device__ __forceinline__ int v_rd_base(int lane) { return ((lane & 3) << 3) | (((lane >> 2) & 3) << 6) | (((lane >> 4) & 1) << 5) | (((lane >> 5) & 1) << 8); }
constexpr int v_rd_off(int d0, int ks, int half) { return d0 * 512 + ks * 4096 + half * 2048; }
template <int OFF> __device__ __forceinline__ s16x4 tr_read(int vb) {
  s16x4 r; asm volatile("ds_read_b64_tr_b16 %0, %1 offset:%2" : "=&v"(r) : "v"(vb), "i"(OFF) : "memory"); return r;
}
template <int D0> __device__ __forceinline__ void pv_one(f32x16& od, int vb, bf16x8 pa0, bf16x8 pa1, bf16x8 pa2, bf16x8 pa3) {
  const s16x4 l0 = tr_read<v_rd_off(D0, 0, 0)>(vb), h0 = tr_read<v_rd_off(D0, 0, 1)>(vb), l1 = tr_read<v_rd_off(D0, 1, 0)>(vb), h1 = tr_read<v_rd_off(D0, 1, 1)>(vb);
  const s16x4 l2 = tr_read<v_rd_off(D0, 2, 0)>(vb), h2 = tr_read<v_rd_off(D0, 2, 1)>(vb), l3 = tr_read<v_rd_off(D0, 3, 0)>(vb), h3 = tr_read<v_rd_off(D0, 3, 1)>(vb);
  asm volatile("s_waitcnt lgkmcnt(0)" ::: "memory"); SBAR();
#define PK(L, H) (bf16x8){L[0], L[1], L[2], L[3], H[0], H[1], H[2], H[3]}
  od = __builtin_amdgcn_mfma_f32_32x32x16_bf16(pa0, PK(l0, h0), od, 0, 0, 0);
  od = __builtin_amdgcn_mfma_f32_32x32x16_bf16(pa1, PK(l1, h1), od, 0, 0, 0);
  od = __builtin_amdgcn_mfma_f32_32x32x16_bf16(pa2, PK(l2, h2), od, 0, 0, 0);
  od = __builtin_amdgcn_mfma_f32_32x32x16_bf16(pa3, PK(l3, h3), od, 0, 0, 0);
#undef PK
}
__device__ __forceinline__ void pv_d0(f32x16* o, int vb, bf16x8 pa0, bf16x8 pa1, bf16x8 pa2, bf16x8 pa3) {
  pv_one<0>(o[0], vb, pa0, pa1, pa2, pa3); pv_one<1>(o[1], vb, pa0, pa1, pa2, pa3); pv_one<2>(o[2], vb, pa0, pa1, pa2, pa3); pv_one<3>(o[3], vb, pa0, pa1, pa2, pa3);
}

__device__ __forceinline__ void apply_mask(f32x16& p0, f32x16& p1, unsigned lo, unsigned hi_) {
#pragma unroll
  for (int r = 0; r < 16; ++r) { const unsigned bit = 1u << ((r & 3) + 8 * (r >> 2));
    p0[r] = (lo & bit) ? p0[r] : -INFINITY; p1[r] = (hi_ & bit) ? p1[r] : -INFINITY; }
}
template <int LDQ, int LDK, int LDO, int MSTR>
__device__ __forceinline__ void att_unit(const bf16_t* __restrict__ Qb, const bf16_t* __restrict__ Kh, const bf16_t* __restrict__ Vh, bf16_t* __restrict__ Ob,
                                         const unsigned long long* __restrict__ mrow, int seq, char* lds) {
  const int tid = otid(), wid = tid >> 6, lane = tid & 63, r32 = lane & 31, hi = lane >> 5;
  bf16_t* V_lds = (bf16_t*)lds; bf16_t* K_lds = (bf16_t*)(lds + 2 * SHM_V);
  float* ws = (float*)(lds + 2 * SHM_V + 2 * SHM_K) + wid * 64; float* li_l = ws; float* al_l = ws + 32;
  float m_reg = -1e30f, l_reg = 0; f32x16 o[4] = {}; bf16x8 qr[8];
  const bf16_t* Qw = Qb + (long)(wid * QBLK + r32) * LDQ + hi * 8;
#pragma unroll
  for (int d0 = 0; d0 < 8; ++d0) qr[d0] = *reinterpret_cast<const bf16x8*>(Qw + d0 * 16);
  const unsigned long long* mq = mrow + wid * QBLK + r32;
  const int sr = tid >> 4, sc = (tid & 15) * 8, vst0 = v_st(sr, sc), vst1 = v_st(32 + sr, sc);
  const int vb0 = (int)(uintptr_t)V_lds + v_rd_base(lane);
  constexpr int SDEPTH = 1, SE = 0, SO = SDEPTH - 1;
  struct { bf16x8 vs0, vs1, ks0, ks1; } sr_[SDEPTH];
#define SLOAD(i, k0) do { sr_[i].vs0 = *reinterpret_cast<const bf16x8*>(&Vh[(long)((k0) + sr) * LDK + sc]); sr_[i].vs1 = *reinterpret_cast<const bf16x8*>(&Vh[(long)((k0) + 32 + sr) * LDK + sc]); \
    sr_[i].ks0 = *reinterpret_cast<const bf16x8*>(&Kh[(long)((k0) + sr) * LDK + sc]); sr_[i].ks1 = *reinterpret_cast<const bf16x8*>(&Kh[(long)((k0) + 32 + sr) * LDK + sc]); } while (0)
#define SWRITE(b, i) do { *(bf16x8*)((char*)V_lds + (b) * SHM_V + vst0) = sr_[i].vs0;          \
    *(bf16x8*)((char*)V_lds + (b) * SHM_V + vst1) = sr_[i].vs1; int kc = sc * 2;               \
    *(bf16x8*)((char*)K_lds + (b) * SHM_K + KSWZ(sr, kc)) = sr_[i].ks0;                       \
    *(bf16x8*)((char*)K_lds + (b) * SHM_K + KSWZ(32 + sr, kc)) = sr_[i].ks1; } while (0)
#define SWAIT() do { if constexpr (SDEPTH == 2) asm volatile("s_waitcnt vmcnt(4)" ::: "memory"); else asm volatile("s_waitcnt vmcnt(0)" ::: "memory"); } while (0)
#define RESC(a) do { if (__any((a) < 1.f)) { if (hi == 0) al_l[r32] = (a); asm volatile("s_waitcnt lgkmcnt(0)" ::: "memory"); \
    for (int d = 0; d < 4; ++d) for (int r = 0; r < 16; ++r) o[d][r] *= al_l[crow(r, hi)]; } } while (0)
#define MLOAD(j) (mq[(long)(j) * MSTR])
#define MASK(P0, P1, mw) apply_mask(P0, P1, (unsigned)(mw) >> (4 * hi), (unsigned)((mw) >> 32) >> (4 * hi))
  f32x16 p0, p1; float mn, al; bf16x8 pa0, pa1, pa2, pa3; const int NT = seq / KVBLK;
  unsigned long long mw;
  SLOAD(SE, 0); mw = MLOAD(0); asm volatile("s_waitcnt vmcnt(0)" ::: "memory"); SWRITE(0, SE); __syncthreads();
  for (int j = 0; j < NT; ++j) {
    const int cur = j & 1; const bool more = (j + 1 < NT);
    if (more) SLOAD(SE, (j + 1) * KVBLK);
    SBAR(); qkt(p0, p1, (bf16_t*)((char*)K_lds + cur * SHM_K), qr, r32, hi);
    MASK(p0, p1, mw); if (more) mw = MLOAD(j + 1);
    partialSM(p0, p1, m_reg, mn, al);
    RESC(al);
    finishSM(p0, p1, al, l_reg, pa0, pa1, pa2, pa3); SBAR();
    pv_d0(o, vb0 + cur * (int)SHM_V, pa0, pa1, pa2, pa3);
    if (more) { SWAIT(); SWRITE(cur ^ 1, SE); }
    __syncthreads();
  }
  if (hi == 0) li_l[r32] = l_reg; asm volatile("s_waitcnt lgkmcnt(0)" ::: "memory");
  float rli[16];
#pragma unroll
  for (int r = 0; r < 16; ++r) rli[r] = __builtin_amdgcn_rcpf(li_l[crow(r, hi)]);
  bf16_t* Ow = Ob + (long)(wid * QBLK) * LDO;
#pragma unroll
  for (int r = 0; r < 16; ++r) { const int orow = crow(r, hi);
#pragma unroll
    for (int d0 = 0; d0 < 4; ++d0) Ow[(long)orow * LDO + d0 * 32 + r32] = (bf16_t)f2bf(o[d0][r] * rli[r]); }
  __syncthreads();
#undef SLOAD
#undef SWRITE
#undef SWAIT
#undef RESC
#undef MLOAD
#undef MASK
}
#undef KSWZ
#undef SBAR
}

namespace ret {
using bf16x8 = __attribute__((ext_vector_type(8))) short;
using s16x4  = __attribute__((ext_vector_type(4))) short;
using f32x16 = __attribute__((ext_vector_type(16))) float;
using f32x4v = __attribute__((ext_vector_type(4))) float;
using u32x4  = __attribute__((ext_vector_type(4))) unsigned;
typedef short v4i16_t __attribute__((ext_vector_type(4)));
constexpr int PITCH = 272;
constexpr int IMG = 64 * PITCH;
__device__ __forceinline__ int crow(int r, int hi) { return (r & 3) + 8 * (r >> 2) + 4 * hi; }
__device__ __forceinline__ s16x4 vtr(const LAS char* p) { return __builtin_bit_cast(s16x4, __builtin_amdgcn_ds_read_tr16_b64_v4i16((LAS v4i16_t*)p)); }
__device__ __forceinline__ bf16x8 tr_frag(const LAS char* img, int r_lo, int r_hi, int cb, int lane) {
    const int i = lane & 15; const LAS char* a = img + (i >> 2) * PITCH + (cb + 4 * (i & 3)) * 2;
    const s16x4 lo = vtr(a + r_lo * PITCH), hi = vtr(a + r_hi * PITCH);
    return (bf16x8){lo[0], lo[1], lo[2], lo[3], hi[0], hi[1], hi[2], hi[3]};
}
__device__ __forceinline__ float l2gamma(int h) { return log1pf(-exp2f(-5.0f - (float)h)) * 1.4426950408889634f; }
template <bool SCALE>
__device__ __forceinline__ void stage_chunk(const bf16_t* src, LAS char* img, float l2g, int tid) {
#pragma unroll
    for (int i = 0; i < 2; ++i) {
        const int idx = tid * 2 + i, row = idx >> 4, c16 = idx & 15;
        u32x4 v = *(const u32x4*)(src + (size_t)row * LDP + c16 * 8);
        if (SCALE) {
            const float sd = exp2f((float)(63 - row) * l2g);
#pragma unroll
            for (int q = 0; q < 4; ++q) { const unsigned w = v[q]; v[q] = pk2(__uint_as_float(w << 16) * sd, __uint_as_float(w & 0xffff0000u) * sd); }
        }
        *(LAS u32x4*)(img + row * PITCH + c16 * 16) = v;
    }
}
__device__ __forceinline__ void r1_unit(int bh, int c, const bf16_t* projb, float* kvt, LAS char* lds) {
    const int tid = otid(), lane = tid & 63, wid = tid >> 6, r32 = lane & 31, hh = lane >> 5;
    const int b = bh >> 3, h = bh & 7; const size_t tok0 = (size_t)b * S + 64 * c;
    const float l2g = l2gamma(h);
    LAS char* kimg = lds; LAS char* vimg = lds + IMG;
    stage_chunk<true>(projb + tok0 * LDP + ORK + h * 128, kimg, l2g, tid);
    stage_chunk<false>(projb + tok0 * LDP + ORV + h * 128, vimg, l2g, tid);
    __syncthreads();
    const int eb = wid >> 1, db0 = (wid & 1) * 2, gcol = 16 * ((lane >> 4) & 1);
    f32x16 acc0 = {}, acc1 = {};
#pragma unroll
    for (int ks = 0; ks < 4; ++ks) {
        const int rl = 16 * ks + 8 * hh;
        const bf16x8 a = tr_frag(vimg, rl, rl + 4, 32 * eb + gcol, lane);
        const bf16x8 b0 = tr_frag(kimg, rl, rl + 4, 32 * db0 + gcol, lane);
        const bf16x8 b1 = tr_frag(kimg, rl, rl + 4, 32 * (db0 + 1) + gcol, lane);
        acc0 = __builtin_amdgcn_mfma_f32_32x32x16_bf16(a, b0, acc0, 0, 0, 0);
        acc1 = __builtin_amdgcn_mfma_f32_32x32x16_bf16(a, b1, acc1, 0, 0, 0);
    }
    float* o = kvt + ((size_t)(bh * 32 + c) * 128 + 32 * eb) * 128 + 32 * db0 + r32;
#pragma unroll
    for (int r = 0; r < 16; ++r) { o[(size_t)crow(r, hh) * 128] = acc0[r]; o[(size_t)crow(r, hh) * 128 + 32] = acc1[r]; }
    __syncthreads();
}
__device__ __forceinline__ void r2_scan(const float* kvt, bf16_t* rt, int G) {
    for (int g4 = blockIdx.x * NTHR + otid(); g4 < 32 * 4096; g4 += G * NTHR) {
        const int bh = g4 >> 12, idx = (g4 & 4095) * 4;
        const float cdk = exp2f(64.0f * l2gamma(bh & 7));
        f32x4v R = {0.f, 0.f, 0.f, 0.f};
        const float* kp = kvt + (size_t)bh * 32 * 16384 + idx; bf16_t* rp = rt + (size_t)bh * 32 * 16384 + idx;
#pragma unroll 4
        for (int c = 0; c < 32; ++c) {
            *(unsigned long long*)(rp + (size_t)c * 16384) = (unsigned long long)pk2(R[0], R[1]) | ((unsigned long long)pk2(R[2], R[3]) << 32);
            if (c < 31) { const f32x4v kv = *(const f32x4v*)(kp + (size_t)c * 16384); R = R * cdk + kv; }
        }
    }
}
__device__ __forceinline__ void r3_unit(int bh, int c, const bf16_t* projb, const bf16_t* rt, const float* rng, bf16_t* catb, LAS char* lds) {
    const int tid = otid(), lane = tid & 63, wid = tid >> 6, r32 = lane & 31, hh = lane >> 5;
    const int b = bh >> 3, h = bh & 7; const size_t tok0 = (size_t)b * S + 64 * c;
    const float l2g = l2gamma(h);
    LAS char* vimg = lds; LAS float* ssp = (LAS float*)(lds + IMG);
    stage_chunk<false>(projb + tok0 * LDP + ORV + h * 128, vimg, l2g, tid);
    const int nt = wid >> 2, eb = wid & 3, gcol = 16 * ((lane >> 4) & 1);
    bf16x8 qf[8];
    { const bf16_t* qp = projb + (tok0 + 32 * nt + r32) * LDP + ORQ + h * 128 + 8 * hh;
#pragma unroll
      for (int ks = 0; ks < 8; ++ks) qf[ks] = *(const bf16x8*)(qp + 16 * ks); }
    f32x16 o2 = {};
    { const bf16_t* rp = rt + ((size_t)(bh * 32 + c) * 128 + 32 * eb + r32) * 128 + 8 * hh;
#pragma unroll
      for (int ks = 0; ks < 8; ++ks) { const bf16x8 rf = *(const bf16x8*)(rp + 16 * ks); o2 = __builtin_amdgcn_mfma_f32_32x32x16_bf16(qf[ks], rf, o2, 0, 0, 0); } }
    __syncthreads();
    f32x16 o1 = {};
    const int n_lane = 32 * nt + r32;
#pragma unroll
    for (int mt = 0; mt < 2; ++mt) {
        if (mt <= nt) {
            f32x16 X = {};
            const bf16_t* kp = projb + (tok0 + 32 * mt + r32) * LDP + ORK + h * 128 + 8 * hh;
#pragma unroll
            for (int ks = 0; ks < 8; ++ks) { const bf16x8 kf = *(const bf16x8*)(kp + 16 * ks); X = __builtin_amdgcn_mfma_f32_32x32x16_bf16(kf, qf[ks], X, 0, 0, 0); }
#pragma unroll
            for (int r = 0; r < 16; ++r) { const int m = 32 * mt + crow(r, hh); X[r] = (n_lane >= m) ? X[r] * exp2f((float)(n_lane - m) * l2g) : 0.f; }
#pragma unroll
            for (int sidx = 0; sidx < 2; ++sidx) {
                u32x4 pw;
#pragma unroll
                for (int q = 0; q < 4; ++q) pw[q] = pk2(X[8 * sidx + 2 * q], X[8 * sidx + 2 * q + 1]);
                const int rl = 32 * mt + 16 * sidx + 4 * hh;
                const bf16x8 vf = tr_frag(vimg, rl, rl + 8, 32 * eb + gcol, lane);
                o1 = __builtin_amdgcn_mfma_f32_32x32x16_bf16(__builtin_bit_cast(bf16x8, pw), vf, o1, 0, 0, 0);
            }
        }
    }
    float o[16];
#pragma unroll
    for (int r = 0; r < 16; ++r) {
        const int n = 32 * nt + crow(r, hh);
        o[r] = o1[r] + o2[r] * exp2f((float)(n + 1) * l2g);
        float sq = o[r] * o[r];
#pragma unroll
        for (int off = 1; off < 32; off <<= 1) sq += __shfl_xor(sq, off);
        if (r32 == 0) ssp[eb * 64 + n] = sq;
    }
    __syncthreads();
    const int e = 32 * eb + r32; const float ge = rng[h * 128 + e];
#pragma unroll
    for (int r = 0; r < 16; ++r) {
        const int n = 32 * nt + crow(r, hh);
        const float tot = (ssp[n] + ssp[64 + n]) + (ssp[128 + n] + ssp[192 + n]);
        const float gt = bf2f(projb[(tok0 + n) * LDP + ORG + h * 128 + e]);
        const float y = o[r] * rsqrtf(tot * (1.0f / 128) + EPS) * ge * (gt / (1.0f + __expf(-gt)));
        catb[(tok0 + n) * D + 1024 + h * 128 + e] = (bf16_t)f2bf(y);
    }
    __syncthreads();
}
}

typedef float f32x4g __attribute__((ext_vector_type(4)));
__device__ __forceinline__ void unpack8(const v4u v, float (&f)[8]) {
#pragma unroll
    for (int q = 0; q < 4; ++q) { f[2 * q] = __uint_as_float(v[q] << 16); f[2 * q + 1] = __uint_as_float(v[q] & 0xffff0000u); }
}
__device__ __forceinline__ v4u pack8(const float (&f)[8]) { v4u o; o.x = pk2(f[0], f[1]); o.y = pk2(f[2], f[3]); o.z = pk2(f[4], f[5]); o.w = pk2(f[6], f[7]); return o; }
__device__ __forceinline__ void pp_token(int t, int lane, bf16_t* pb, float* iwf, bf16_t* ikc, const float* qg, const float* kg, const float* lnw, const float* lnb, const float2* rot) {
    bf16_t* p = pb + (size_t)t * LDP;
#pragma unroll
    for (int i = 0; i < 3; ++i) {
        const int chunk = 64 * i + lane;
        if (chunk < 160) {
            float f[8]; unpack8(*(const v4u*)(p + chunk * 8), f);
            float ss = 0.f;
#pragma unroll
            for (int j = 0; j < 8; ++j) ss += f[j] * f[j];
            ss += __shfl_xor(ss, 1); ss += __shfl_xor(ss, 2); ss += __shfl_xor(ss, 4); ss += __shfl_xor(ss, 8);
            const float r = rsqrtf(ss * (1.0f / 128) + EPS);
            const float* g = ((chunk >> 4) < 8 ? qg : kg) + (chunk & 15) * 8;
            const f32x4g g0 = *(const f32x4g*)g, g1 = *(const f32x4g*)(g + 4);
            f[0] *= r * g0[0]; f[1] *= r * g0[1]; f[2] *= r * g0[2]; f[3] *= r * g0[3]; f[4] *= r * g1[0]; f[5] *= r * g1[1]; f[6] *= r * g1[2]; f[7] *= r * g1[3];
            *(v4u*)(p + chunk * 8) = pack8(f);
        }
    }
    {
        const bool act = lane < 8; const int c = act ? lane : 0;
        float f[8]; unpack8(*(const v4u*)(p + OIK + c * 8), f);
        float sm_ = 0.f;
#pragma unroll
        for (int j = 0; j < 8; ++j) sm_ += f[j];
        sm_ += __shfl_xor(sm_, 1); sm_ += __shfl_xor(sm_, 2); sm_ += __shfl_xor(sm_, 4);
        const float mean = sm_ * (1.0f / 64);
        float vs = 0.f;
#pragma unroll
        for (int j = 0; j < 8; ++j) { f[j] -= mean; vs += f[j] * f[j]; }
        vs += __shfl_xor(vs, 1); vs += __shfl_xor(vs, 2); vs += __shfl_xor(vs, 4);
        const float r = rsqrtf(vs * (1.0f / 64) + EPS);
#pragma unroll
        for (int j = 0; j < 8; ++j) f[j] = f[j] * r * lnw[c * 8 + j] + lnb[c * 8 + j];
        if (act) { const v4u o = pack8(f); *(v4u*)(p + OIK + c * 8) = o; *(v4u*)(ikc + (size_t)t * 64 + c * 8) = o; }
    }
    if (lane < 16) iwf[(size_t)t * 16 + lane] = bf2f(p[OIW + lane]) * 0.03125f;
    const int tl = t & (S - 1);
#pragma unroll
    for (int i = 0; i < 2; ++i) {
        const int task = 64 * i + lane, inst = task >> 3, c = task & 7;
        bf16_t* r = p + ORQ + inst * 128 + c * 8;
        float x1[8], x2[8]; unpack8(*(const v4u*)r, x1); unpack8(*(const v4u*)(r + 64), x2);
        const float sc = (inst >= 8) ? 0.08838834764831845f : 1.f;
        const float2* cs = rot + tl * 64 + c * 8;
        float y1[8], y2[8];
#pragma unroll
        for (int j = 0; j < 8; ++j) { const float2 q = cs[j]; y1[j] = (x1[j] * q.x - x2[j] * q.y) * sc; y2[j] = (x1[j] * q.y + x2[j] * q.x) * sc; }
        *(v4u*)r = pack8(y1); *(v4u*)(r + 64) = pack8(y2);
    }
}

__device__ __forceinline__ void router_pass(int t0, int T_, int lane, LAS float* lsm, const float* x1, const float* g2, const float* wr, bf16_t* xn2, int* eid, float* ew, int* cnt) {
    LAS float* wgT = lsm; LAS float* wrc = lsm + 8192;
    f32x4g ha[8], hb[8];
    {
        const f32x4g* xa = (const f32x4g*)(x1 + (size_t)t0 * D) + lane; const f32x4g* xb = xa + D / 4; const f32x4g* gp = (const f32x4g*)g2 + lane;
        float sa = 0.f, sb_ = 0.f;
#pragma unroll
        for (int j = 0; j < 8; ++j) { ha[j] = xa[64 * j]; hb[j] = xb[64 * j];
            sa += (ha[j][0] * ha[j][0] + ha[j][1] * ha[j][1]) + (ha[j][2] * ha[j][2] + ha[j][3] * ha[j][3]);
            sb_ += (hb[j][0] * hb[j][0] + hb[j][1] * hb[j][1]) + (hb[j][2] * hb[j][2] + hb[j][3] * hb[j][3]); }
        const float ra = rsqrtf(wave_sum(sa) * (1.0f / D) + EPS), rb = rsqrtf(wave_sum(sb_) * (1.0f / D) + EPS);
        unsigned long long* oa = (unsigned long long*)(xn2 + (size_t)t0 * D) + lane; unsigned long long* ob = oa + D / 4;
#pragma unroll
        for (int j = 0; j < 8; ++j) { const f32x4g gg = gp[64 * j]; ha[j] = ha[j] * ra * gg; hb[j] = hb[j] * rb * gg;
            oa[64 * j] = (unsigned long long)pk2(ha[j][0], ha[j][1]) | ((unsigned long long)pk2(ha[j][2], ha[j][3]) << 32);
            ob[64 * j] = (unsigned long long)pk2(hb[j][0], hb[j][1]) | ((unsigned long long)pk2(hb[j][2], hb[j][3]) << 32); }
    }
    float ga[4], gb[4];
#pragma unroll
    for (int c = 0; c < 4; ++c) { float a = 0.f, b = 0.f;
#pragma unroll
        for (int j = 0; j < 8; ++j) { const f32x4g w = *(const LAS f32x4g*)(wgT + c * 2048 + 256 * j + 4 * lane);
            a += (ha[j][0] * w[0] + ha[j][1] * w[1]) + (ha[j][2] * w[2] + ha[j][3] * w[3]); b += (hb[j][0] * w[0] + hb[j][1] * w[1]) + (hb[j][2] * w[2] + hb[j][3] * w[3]); }
        ga[c] = wave_sum(a); gb[c] = wave_sum(b); }
    int gsa = 0, gsb = 0; float gma = ga[0], gmb = gb[0];
#pragma unroll
    for (int c = 1; c < 4; ++c) { if (ga[c] > gma) { gma = ga[c]; gsa = c; } if (gb[c] > gmb) { gmb = gb[c]; gsb = c; } }
    float dena = 0.f, denb = 0.f;
#pragma unroll
    for (int c = 0; c < 4; ++c) { dena += expf(ga[c] - gma); denb += expf(gb[c] - gmb); }
    float ea[8], eb[8];
#pragma unroll
    for (int e = 0; e < 8; ++e) { ea[e] = 0.f; eb[e] = 0.f; }
#pragma unroll
    for (int j = 0; j < 8; ++j) {
        __syncthreads();
#pragma unroll
        for (int q = 0; q < 4; ++q) { const int i4 = T_ + NTHR * q, g = i4 >> 9, rem = i4 & 511, dd = rem >> 1, e0 = (rem & 1) * 4;
            const f32x4g w = *(const f32x4g*)(wr + ((size_t)g * D + 256 * j + dd) * 8 + e0);
            LAS float* dst = wrc + (g * 8 + e0) * 256 + dd; dst[0] = w[0]; dst[256] = w[1]; dst[512] = w[2]; dst[768] = w[3]; }
        __syncthreads();
#pragma unroll
        for (int e = 0; e < 8; ++e) {
            const f32x4g wa = *(const LAS f32x4g*)(wrc + (gsa * 8 + e) * 256 + 4 * lane), wb = *(const LAS f32x4g*)(wrc + (gsb * 8 + e) * 256 + 4 * lane);
            ea[e] += (ha[j][0] * wa[0] + ha[j][1] * wa[1]) + (ha[j][2] * wa[2] + ha[j][3] * wa[3]);
            eb[e] += (hb[j][0] * wb[0] + hb[j][1] * wb[1]) + (hb[j][2] * wb[2] + hb[j][3] * wb[3]); }
    }
#pragma unroll
    for (int e = 0; e < 8; ++e) { ea[e] = wave_sum(ea[e]); eb[e] = wave_sum(eb[e]); }
    {
        const bool second = (lane == 1);
        float el[8];
#pragma unroll
        for (int e = 0; e < 8; ++e) el[e] = second ? eb[e] : ea[e];
        const int gs = second ? gsb : gsa; const float gate = 1.0f / (second ? denb : dena);
        int i0 = 0; float m0 = el[0];
#pragma unroll
        for (int e = 1; e < 8; ++e) if (el[e] > m0) { m0 = el[e]; i0 = e; }
        int i1 = -1; float m1 = -INFINITY;
#pragma unroll
        for (int e = 0; e < 8; ++e) if (e != i0 && (i1 < 0 || el[e] > m1)) { m1 = el[e]; i1 = e; }
        const float e1 = expf(m1 - m0); const float w0 = 1.0f / (1.0f + e1) * gate, w1 = e1 / (1.0f + e1) * gate;
        if (lane < 2) { const int t = t0 + lane;
            eid[t * 2] = gs * 8 + i0; eid[t * 2 + 1] = gs * 8 + i1; ew[t * 2] = w0; ew[t * 2 + 1] = w1;
            atomicAdd(&cnt[gs * 8 + i0], 1); atomicAdd(&cnt[gs * 8 + i1], 1); }
    }
}

__device__ __forceinline__ void fill_token(int t, int lane, const int* soff, const bf16_t* h2, const int* eid, const float* ew, int* fill, int* slot_of, float* slotw, bf16_t* xg) {
    int slot = 0;
    if (lane < 2) { const int e = eid[t * 2 + lane]; slot = soff[e] + atomicAdd(&fill[e], 1); slot_of[t * 2 + lane] = slot; slotw[slot] = ew[t * 2 + lane]; }
    const int s0 = __shfl(slot, 0), s1 = __shfl(slot, 1);
    const v4u* src = (const v4u*)(h2 + (size_t)t * D) + lane; v4u* d0 = (v4u*)(xg + (size_t)s0 * D) + lane; v4u* d1 = (v4u*)(xg + (size_t)s1 * D) + lane;
#pragma unroll
    for (int j = 0; j < 4; ++j) { const v4u v = src[64 * j]; d0[64 * j] = v; d1[64 * j] = v; }
}
__device__ __forceinline__ void combine_token(int t, int lane, float* out, const bf16_t* y, const int* slot_of) {
    const int s0 = slot_of[t * 2], s1 = slot_of[t * 2 + 1];
    const v4u* y0 = (const v4u*)(y + (size_t)s0 * D) + lane; const v4u* y1 = (const v4u*)(y + (size_t)s1 * D) + lane;
    f32x4g* o = (f32x4g*)(out + (size_t)t * D) + 2 * lane;
#pragma unroll
    for (int j = 0; j < 4; ++j) {
        float a[8], b[8]; unpack8(y0[64 * j], a); unpack8(y1[64 * j], b);
        f32x4g o0 = o[128 * j], o1 = o[128 * j + 1];
        o0[0] += a[0] + b[0]; o0[1] += a[1] + b[1]; o0[2] += a[2] + b[2]; o0[3] += a[3] + b[3];
        o1[0] += a[4] + b[4]; o1[1] += a[5] + b[5]; o1[2] += a[6] + b[6]; o1[3] += a[7] + b[7];
        o[128 * j] = o0; o[128 * j + 1] = o1;
    }
}

#define XB_TMO      128
#define XB_XCNT(j)  (256  + 64 * (j))
#define XB_XSUB(j)  (1280 + 64 * (j))
#define XB_XGEN(j)  (2304 + 64 * (j))
#define XB_TOP      3328
#define XB_TOPGEN   3392
#define XCD_BAR_WORDS 3456
#define XB_SPIN_CAP (1u << 18)

__device__ __forceinline__ unsigned xb_ld(unsigned* p)              { return __hip_atomic_load(p, __ATOMIC_RELAXED, __HIP_MEMORY_SCOPE_AGENT); }
__device__ __forceinline__ unsigned xb_add(unsigned* p, unsigned v) { return __hip_atomic_fetch_add(p, v, __ATOMIC_RELAXED, __HIP_MEMORY_SCOPE_AGENT); }
__device__ __forceinline__ unsigned xb_xcc_id() { return (unsigned)__builtin_amdgcn_s_getreg((3 << 11) | 20) & 0xFu; }
#define XB_SPIN(cond, bar) do { unsigned _sp = 0; while (cond) { __builtin_amdgcn_s_sleep(1); \
    if ((++_sp & 255u) == 0u) { if (xb_ld(&(bar)[XB_TMO])) break; if (_sp > XB_SPIN_CAP) { atomicAdd(&(bar)[XB_TMO], 1u); break; } } } } while (0)

struct XcdBarrier {
    unsigned* bar; unsigned x;
    volatile LAS unsigned* st;
};

__device__ __forceinline__ XcdBarrier xcd_barrier_post(unsigned* bar, volatile LAS unsigned* st) {
    XcdBarrier b; b.bar = bar; b.x = xb_xcc_id(); b.st = st;
    if (threadIdx.x == 0) (void)xb_add(&bar[XB_XCNT(b.x)], 1u);
    return b;
}
__device__ __forceinline__ void xcd_barrier_complete(unsigned* bar, unsigned x, unsigned& nloc, unsigned& nx) {
    const unsigned G = gridDim.x * gridDim.y * gridDim.z;
    unsigned sum, cnt, mine, sp = 0u;
    for (;;) {
        sum = 0u; cnt = 0u; mine = 0u;
#pragma unroll
        for (unsigned j = 0; j < 16; ++j) { const unsigned c = xb_ld(&bar[XB_XCNT(j)]); sum += c; cnt += (c > 0u) ? 1u : 0u; mine = (j == x) ? c : mine; }
        if (sum == G) break;
        __builtin_amdgcn_s_sleep(1);
        if ((++sp & 255u) == 0u) { if (xb_ld(&bar[XB_TMO])) break; if (sp > XB_SPIN_CAP) { atomicAdd(&bar[XB_TMO], 1u); break; } }
    }
    nloc = mine > 0u ? mine : 1u; nx = cnt > 0u ? cnt : 1u;
}

__device__ __forceinline__ void xcd_barrier(const XcdBarrier& b) {
    asm volatile("s_waitcnt vmcnt(0)" ::: "memory");
    __syncthreads();
    if (threadIdx.x == 0) {
        unsigned* bar = b.bar;
        __builtin_amdgcn_s_waitcnt(0);
        unsigned nloc = b.st[0], nx = b.st[1];
        if (nloc == 0u) { xcd_barrier_complete(bar, b.x, nloc, nx); b.st[0] = nloc; b.st[1] = nx; }
        const unsigned old = xb_add(&bar[XB_XSUB(b.x)], 1u);
        const unsigned gen = old / nloc;
        if (old + 1u == (gen + 1u) * nloc) {
            __builtin_amdgcn_fence(__ATOMIC_RELEASE, "agent");
            asm volatile("s_waitcnt vmcnt(0)" ::: "memory");
            const unsigned og = xb_add(&bar[XB_TOP], 1u);
            const unsigned tg = og / nx;
            if (og + 1u == (tg + 1u) * nx) xb_add(&bar[XB_TOPGEN], 1u);
            else XB_SPIN(xb_ld(&bar[XB_TOPGEN]) == tg, bar);
            __builtin_amdgcn_fence(__ATOMIC_ACQUIRE, "agent");
            xb_add(&bar[XB_XGEN(b.x)], 1u);
            asm volatile("s_waitcnt vmcnt(0)" ::: "memory");
        } else {
            XB_SPIN(xb_ld(&bar[XB_XGEN(b.x)]) == gen, bar);
            __builtin_amdgcn_fence(__ATOMIC_ACQUIRE, "agent");
            asm volatile("s_waitcnt vmcnt(0)" ::: "memory");
        }
    }
    __syncthreads();
}

__global__ void __launch_bounds__(NTHR, 2) mega(Params P) {
    extern __shared__ __attribute__((aligned(16))) unsigned char lds[];
    cg::grid_group grid = cg::this_grid();
    int* soff = (int*)(lds + 2 * SUB_LDS);
    volatile LAS unsigned* bst = (volatile LAS unsigned*)((LAS unsigned char*)lds + 2 * SUB_LDS + 256);
    if (threadIdx.x < 4) bst[threadIdx.x] = 0u;
    __syncthreads();
    const XcdBarrier xbar = xcd_barrier_post((unsigned*)(P.ws + WS_BAR), bst);
    const int G = gridDim.x, nsb = G * 2, NGW = G * NWAVES;
#define PHASE_IDS() const int T_ = otid(); const int sub = T_ >> 8, tid = T_ & 255, lane = T_ & 63, wave = __builtin_amdgcn_readfirstlane(T_ >> 6); \
    float* sm = (float*)(lds + sub * SUB_LDS); const int sb = blockIdx.x * 2 + sub, gw = blockIdx.x * NWAVES + wave; (void)tid; (void)lane; (void)sm; (void)sb; (void)gw;
    char* ws = P.ws;
    int* cnt = (int*)(ws + WS_CTL); int* fill = cnt + 32; int* off = cnt + 64; int* tile_e = cnt + 256;
    int* eid = (int*)(ws + WS_EID); float* ew = (float*)(ws + WS_EW); int* slot_of = (int*)(ws + WS_SLOT); float* slotw = (float*)(ws + WS_SLOTW);
    float2* rot = (float2*)(ws + WS_ROT);
    bf16_t* projb = (bf16_t*)(ws + WS_PROJB); unsigned long long* maskw = (unsigned long long*)(ws + WS_MASK); bf16_t* ikc = (bf16_t*)(ws + WS_IKC); bf16_t* catb = (bf16_t*)(ws + WS_CATB);
    bf16_t* xgb = (bf16_t*)(ws + WS_PROJB); bf16_t* yb = xgb; bf16_t* hhb = (bf16_t*)(ws + WS_CATB);
    bf16_t* wint = (bf16_t*)(ws + WS_WINT); bf16_t* woutt = (bf16_t*)(ws + WS_WOUTT); bf16_t* w13t = (bf16_t*)(ws + WS_W13T); bf16_t* w2t = (bf16_t*)(ws + WS_W2T);
    bf16_t* xn = (bf16_t*)(ws + WS_XN); bf16_t* xn2 = xn; float* kvt = (float*)(ws + WS_KVT); bf16_t* rtb = (bf16_t*)(ws + WS_RT); float* iwf = (float*)(ws + WS_IWF);

    { PHASE_IDS();
    for (int idx = blockIdx.x * NTHR + T_; idx < 2048 * 64; idx += G * NTHR) {
        const int pos = idx >> 6, i = idx & 63;
        const double inv = exp(-log(10000.0) * (double)i / 63.0);
        const double ang = (double)pos * inv;
        rot[idx] = make_float2((float)cos(ang), (float)sin(ang));
    }
    {
        LAS float* scr = (LAS float*)((LAS unsigned char*)lds + wave * 16384);
        constexpr int I_IN = (D / 64) * (LDP / 32), I_OUT = (D / 64) * (D / 32), I_13 = NE * (D / 64) * (FF / 32), I_2 = NE * (FF / 64) * (D / 32);
        constexpr int NITEMS = I_IN + I_OUT + 2 * I_13 + I_2;
        for (int it = gw; it < NITEMS; it += NGW) {
            int r = it;
            if (r < I_IN) { const int nb = r % (LDP / 32), kb = r / (LDP / 32); p0_transpose_item(P.w_in, D, INW, 64 * kb, 32 * nb, wint, 32 * nb, scr, lane); continue; } r -= I_IN;
            if (r < I_OUT) { const int nb = r % (D / 32), kb = r / (D / 32); p0_transpose_item(P.w_out, D, D, 64 * kb, 32 * nb, woutt, 32 * nb, scr, lane); continue; } r -= I_OUT;
            if (r < 2 * I_13) {
                const int which = r / I_13; r -= which * I_13;
                const int e = r / ((D / 64) * (FF / 32)); r -= e * ((D / 64) * (FF / 32));
                const int nb = r % (FF / 32), kb = r / (FF / 32), n0 = 32 * nb;
                const float* W = (which ? P.w3 : P.w1) + (size_t)e * D * FF;
                p0_transpose_item(W, D, FF, 64 * kb, n0, w13t + (size_t)e * 1024 * D, (n0 >> 7) * 256 + which * 128 + (n0 & 127), scr, lane); continue; }
            r -= 2 * I_13;
            { const int e = r / ((FF / 64) * (D / 32)); r -= e * ((FF / 64) * (D / 32));
              const int nb = r % (D / 32), kb = r / (D / 32);
              p0_transpose_item(P.w2 + (size_t)e * FF * D, FF, D, 64 * kb, 32 * nb, w2t + (size_t)e * D * FF, 32 * nb, scr, lane); }
        }
        for (int m = gw; m < NT; m += NGW) rms_row_to_bf16(P.x + (size_t)m * D, P.norm1_g, xn + (size_t)m * D, lane);
    }
    }
    grid.sync();
    {
        pg8::Gemm g{xn, wint, NT, LDP, D}; pg8::StaticOrder SO; SO.init(NT, LDP, G, (int)blockIdx.x);
        pg8::EpiBf16 E{projb, LDP};
        pg8::gemm_phase<pg8::EpiBf16, pg8::StaticOrder, true, true>((LAS unsigned char*)lds, g, SO, E);
    }
    xcd_barrier(xbar);
    { PHASE_IDS(); for (int t = gw; t < NT; t += NGW) pp_token(t, lane, projb, iwf, ikc, P.q_norm_g, P.k_norm_g, P.ln_w, P.ln_b, rot); }
    xcd_barrier(xbar);
    { PHASE_IDS();
    for (int i = 0; i * G + (int)blockIdx.x < NT / 16; ++i) {
        const int L = i * G + (int)blockIdx.x;
        const int u = (L < 256) ? L : 256 + (L & 128) + (127 - (L & 127));
        idx_pair(u * 16 + wave * 2, projb, ikc, iwf, maskw, lane);
    }
    }
    __syncthreads();
    for (int u = blockIdx.x; u < 1024; u += G) { if ((u & 31) != 31) ret::r1_unit(u >> 5, u & 31, projb, kvt, (LAS char*)lds); }
    xcd_barrier(xbar);
    for (int u = blockIdx.x; u < 256; u += G) {
        const int bg = u & 7, k = u >> 3, bb = bg >> 1, g = bg & 1, h = g * 4 + (k & 3), qb = k >> 2;
        const size_t row0 = (size_t)bb * S;
        att::att_unit<LDP, LDP, D, S>(projb + (row0 + 256 * qb) * LDP + OQ + h * 128, projb + row0 * LDP + OKK + g * 128, projb + row0 * LDP + OV + g * 128,
                                      catb + (row0 + 256 * qb) * D + h * 128, maskw + (size_t)(bb * 32) * S + 256 * qb, 256 * (qb + 1), (char*)lds);
    }
    ret::r2_scan(kvt, rtb, G);
    xcd_barrier(xbar);
    for (int u = blockIdx.x; u < 1024; u += G) ret::r3_unit(u >> 5, u & 31, projb, rtb, P.ret_g, catb, (LAS char*)lds);
    xcd_barrier(xbar);
    {
        pg8::Gemm g{catb, woutt, NT, D, D}; pg8::StaticOrder SO; SO.init(NT, D, G, (int)blockIdx.x);
        pg8::EpiF32Res E{P.x, P.out, D};
        pg8::gemm_phase<pg8::EpiF32Res, pg8::StaticOrder, true, true>((LAS unsigned char*)lds, g, SO, E);
    }
    xcd_barrier(xbar);
    { PHASE_IDS();
      LAS float* lsm = (LAS float*)(LAS unsigned char*)lds;
      for (int d = T_; d < D; d += NTHR) { const f32x4g w = *(const f32x4g*)(P.w_group + (size_t)d * 4); lsm[d] = w[0]; lsm[2048 + d] = w[1]; lsm[4096 + d] = w[2]; lsm[6144 + d] = w[3]; }
      __syncthreads();
      for (int pass = blockIdx.x; pass < NT / 16; pass += G) router_pass(pass * 16 + wave * 2, T_, lane, lsm, P.out, P.norm2_g, P.w_router, xn2, eid, ew, cnt);
    }
    xcd_barrier(xbar);
    { PHASE_IDS();
    if (T_ == 0) {
        int o = 0;
        for (int e = 0; e < NE; ++e) {
            soff[e] = o; const int nt = (cnt[e] + 255) / 256;
            if (blockIdx.x == 0) { off[e] = o; for (int i = 0; i < nt; ++i) tile_e[o / 256 + i] = e; }
            o += nt * 256;
        }
        soff[NE] = o;
        if (blockIdx.x == 0) { off[NE] = o; for (int i = o / 256; i < MAXTILES; ++i) tile_e[i] = 0; }
    }
    __syncthreads();
    for (int t = gw; t < NT; t += NGW) fill_token(t, lane, soff, xn2, eid, ew, fill, slot_of, slotw, xgb);
    for (int e = blockIdx.x; e < NE; e += G) {
        const int r0 = soff[e] + cnt[e], r1 = soff[e + 1];
        for (int r = r0; r < r1; ++r) {
            if (T_ == 0) slotw[r] = 0.f;
            if (T_ < 256) *(v4u*)(xgb + (size_t)r * D + T_ * 8) = (v4u){0u, 0u, 0u, 0u};
        }
    }
    }
    xcd_barrier(xbar);
    const int mtiles = off[NE] / 256;
    {
        pg8::Gemm g{xgb, w13t, MAXROWS, 1024, D}; pg8::GroupedOrder SO{tile_e, mtiles, 4, G, (int)blockIdx.x, (size_t)1024 * D};
        pg8::EpiSwiglu E{hhb, FF, slotw};
        pg8::gemm_phase<pg8::EpiSwiglu, pg8::GroupedOrder, true, true>((LAS unsigned char*)lds, g, SO, E);
    }
    xcd_barrier(xbar);
    {
        pg8::Gemm g{hhb, w2t, MAXROWS, D, FF}; pg8::GroupedOrder SO{tile_e, mtiles, 8, G, (int)blockIdx.x, (size_t)D * FF};
        pg8::EpiBf16 E{yb, D};
        pg8::gemm_phase<pg8::EpiBf16, pg8::GroupedOrder, true, true>((LAS unsigned char*)lds, g, SO, E);
    }
    xcd_barrier(xbar);
    { PHASE_IDS();
    for (int t = gw; t < NT; t += NGW) combine_token(t, lane, P.out, yb, slot_of);
    }
}

extern "C" void kernel_launch(void* const* d_in, const int* in_sizes, int n_in, void* d_out, int out_size, void* d_ws, size_t ws_size, hipStream_t stream) {
    static int grid_blocks = 0;
    if (grid_blocks == 0) {
        if (n_in != 15 || in_sizes[0] != NT * D || out_size != NT * D || ws_size < WS_END) {
            fprintf(stderr, "kernel_launch: unexpected shapes n_in %d in0 %d out %d ws %zu\n", n_in, n_in > 0 ? in_sizes[0] : -1, out_size, ws_size);
            grid_blocks = -1; return;
        }
        int dev = 0, cus = 0, per_cu = 0;
        (void)hipGetDevice(&dev);
        (void)hipDeviceGetAttribute(&cus, hipDeviceAttributeMultiprocessorCount, dev);
        (void)hipFuncSetAttribute((const void*)mega, hipFuncAttributeMaxDynamicSharedMemorySize, LDS_BYTES);
        (void)hipOccupancyMaxActiveBlocksPerMultiprocessor(&per_cu, (const void*)mega, NTHR, LDS_BYTES);
        if (per_cu < 1) { fprintf(stderr, "kernel_launch: occupancy query says %d blocks/CU\n", per_cu); per_cu = 1; }
        if (per_cu > 1) per_cu = 1;
        grid_blocks = 1; while (grid_blocks * 2 <= cus * per_cu) grid_blocks *= 2;
        fprintf(stderr, "kernel_launch: grid %d (cus %d)\n", grid_blocks, cus);
    }
    if (grid_blocks < 0) return;
    (void)hipMemsetAsync((char*)d_ws + WS_CTL, 0, 32768, stream);
    Params p{};
    p.x = (const float*)d_in[0]; p.norm1_g = (const float*)d_in[1]; p.w_in = (const float*)d_in[2]; p.q_norm_g = (const float*)d_in[3];
    p.k_norm_g = (const float*)d_in[4]; p.ln_w = (const float*)d_in[5]; p.ln_b = (const float*)d_in[6]; p.ret_g = (const float*)d_in[7];
    p.w_out = (const float*)d_in[8]; p.norm2_g = (const float*)d_in[9]; p.w_group = (const float*)d_in[10]; p.w_router = (const float*)d_in[11];
    p.w1 = (const float*)d_in[12]; p.w3 = (const float*)d_in[13]; p.w2 = (const float*)d_in[14];
    p.out = (float*)d_out; p.ws = (char*)d_ws;
    void* args[] = {&p};
    hipError_t e = hipLaunchCooperativeKernel((const void*)mega, dim3(grid_blocks), dim3(NTHR), args, LDS_BYTES, stream);
    if (e != hipSuccess) fprintf(stderr, "cooperative launch failed: %s (grid %d)\n", hipGetErrorString(e), grid_blocks);
}
```

```cpp
#include <hip/hip_runtime.h>
#include <hip/hip_cooperative_groups.h>
#include <cstdint>
#include <cstdio>
namespace cg = cooperative_groups;
__device__ __forceinline__ int otid() { int t = threadIdx.x; asm volatile("" : "+v"(t)); return t; }

namespace cfg {
constexpr int B = 4, S = 2048, D = 2048, NT = B * S;
constexpr int INW = 6736, LDP = 6912;
constexpr int OQ = 0, OKK = 1024, OV = 1280, OIQ = 1536, OIK = 2560, OIW = 2624, ORQ = 2640, ORK = 3664, ORV = 4688, ORG = 5712;
constexpr int NE = 32, FF = 512;
constexpr float EPS = 1e-6f;
constexpr int MAXROWS = 16384 + 32 * 256;
constexpr int MAXTILES = MAXROWS / 256;
constexpr int NTHR = 512, NWAVES = 8;
constexpr int LDS_BYTES = 147456;
constexpr int SUB_LDS = 65536;
}
using namespace cfg;

constexpr size_t MiB = 1u << 20;
constexpr size_t WS_CTL = 0;
constexpr size_t WS_ROWMAP = 32 * 1024;
constexpr size_t WS_BAR = 16 * 1024;
constexpr size_t WS_EID = 128 * 1024;
constexpr size_t WS_EW = 192 * 1024;
constexpr size_t WS_SLOT = 256 * 1024;
constexpr size_t WS_SLOTW = 320 * 1024;
constexpr size_t WS_IWF = 448 * 1024;
constexpr size_t WS_ROT = 1 * MiB;
constexpr size_t WS_WINT = 2 * MiB;
constexpr size_t WS_WOUTT = 29 * MiB;
constexpr size_t WS_W13T = 37 * MiB;
constexpr size_t WS_W2T = 165 * MiB;
constexpr size_t WS_XN = 229 * MiB;
constexpr size_t WS_PROJB = 261 * MiB;
constexpr size_t WS_CATB = 369 * MiB;
constexpr size_t WS_MASK = 401 * MiB;
constexpr size_t WS_IKC = 403 * MiB;
constexpr size_t WS_KVT = 404 * MiB;
constexpr size_t WS_RT = WS_XN;
constexpr size_t WS_WRT = 468 * MiB;
constexpr size_t WS_END = 469 * MiB;

struct Params {
    const float *x, *norm1_g, *w_in, *q_norm_g, *k_norm_g, *ln_w, *ln_b, *ret_g, *w_out, *norm2_g, *w_group, *w_router, *w1, *w3, *w2;
    float* out;
    char* ws;
};
namespace pg8 {
#define PG8_LAS __attribute__((address_space(3)))
typedef unsigned short bf16_t;
typedef short bf16x8 __attribute__((ext_vector_type(8)));
typedef float f32x4 __attribute__((ext_vector_type(4)));
typedef unsigned u32x4 __attribute__((ext_vector_type(4)));
constexpr int BM = 256, BK = 64, HALF = 128, HTB = HALF * BK * 2  , STAGE_BYTES = 8 * HTB, NXCD = 8, WGM = 8;

__host__ __device__ __forceinline__ int lds_byte(int r, int c) { const int st = (r >> 4) * 2 + (c >> 5), rr = r & 15, cc = c & 31, ob = rr * 64 + cc * 2; return st * 1024 + (ob ^ (((ob >> 9) & 1) << 5)); }
__host__ __device__ __forceinline__ void stage_rc(int b, int& R, int& C) { const int st = b / 1024, sb = b % 1024, swz = sb ^ (((sb >> 9) & 1) << 5); R = (st >> 1) * 16 + swz / 64; C = (st & 1) * 32 + (swz % 64) / 2; }
__host__ __device__ __forceinline__ int perm32(int rho) { const int n = rho >> 4, i = rho & 15; return 8 * (i >> 2) + 4 * n + (i & 3); }

struct Unit { int pm, pn; };
struct Gemm { const bf16_t* A; const bf16_t* Bt; int M, N, K; };

struct StaticOrder {
    int nM, nN, nwg, G, c;
    __host__ __device__ void init(int M, int N, int G_, int c_) { nM = M / BM; nN = N / BM; nwg = nM * nN; G = G_; c = c_; }
    __host__ __device__ bool next(int i, Unit& u) const {
        const long L = (long)i * G + c; if (L >= nwg) return false;
        int wgid = (int)L; { const int q = nwg / NXCD, r = nwg % NXCD, xcd = wgid % NXCD, off = wgid / NXCD; wgid = (xcd < r ? xcd * (q + 1) : r * (q + 1) + (xcd - r) * q) + off; }
        const int nig = WGM * nN, gid = wgid / nig, fm = gid * WGM, gsz = (nM - fm) < WGM ? (nM - fm) : WGM;
        u.pm = fm + ((wgid % nig) % gsz); u.pn = (wgid % nig) / gsz; return true;
    }
    __device__ __forceinline__ void a_ready(const Unit&) const {}
    __device__ __forceinline__ void done(const Unit&) const {}
    __device__ __forceinline__ const bf16_t* b_base(const Unit&, const bf16_t* Bt) const { return Bt; }
    __device__ __forceinline__ int a_row(const Unit& u, int r) const { return u.pm * BM + r; }
};
struct GroupedOrder {
    const int* tile_e; int ntiles, nN, G, c; size_t strideB; const int* rowmap;
    __device__ __forceinline__ bool next(int i, Unit& u) const { const long L = (long)i * G + c; if (L >= (long)ntiles * nN) return false; u.pm = (int)(L / nN); u.pn = (int)(L % nN); return true; }
    __device__ __forceinline__ void a_ready(const Unit&) const {}
    __device__ __forceinline__ void done(const Unit&) const {}
    __device__ __forceinline__ const bf16_t* b_base(const Unit& u, const bf16_t* Bt) const { return Bt + (size_t)tile_e[u.pm] * strideB; }
    __device__ __forceinline__ int a_row(const Unit& u, int r) const { return rowmap ? rowmap[u.pm * BM + r] : u.pm * BM + r; }
};


__device__ __forceinline__ unsigned cvt_pk_bf16(float lo, float hi) { unsigned r; asm volatile("v_cvt_pk_bf16_f32 %0, %1, %2" : "=v"(r) : "v"(lo), "v"(hi)); return r; }
struct EpiBf16 {
    static constexpr bool PERM = true, AFTER_DRAIN = false;
    bf16_t* O; int ldc;
    __device__ __forceinline__ void operator()(const f32x4 (&acc)[2][2][4][2], const Unit& u, int wr, int wc, int fr, int fq) const {
        const int row0 = u.pm * BM + wr * 64 + fr; const int col0 = u.pn * BM + wc * 32 + 8 * fq;
#pragma unroll
        for (int ai = 0; ai < 2; ++ai)
#pragma unroll
            for (int m = 0; m < 4; ++m) { bf16_t* rowp = O + (size_t)(row0 + ai * HALF + m * 16) * ldc + col0;
#pragma unroll
                for (int bj = 0; bj < 2; ++bj) { const f32x4 v0 = acc[ai][bj][m][0], v1 = acc[ai][bj][m][1];
                    u32x4 w; w.x = cvt_pk_bf16(v0[0], v0[1]); w.y = cvt_pk_bf16(v0[2], v0[3]); w.z = cvt_pk_bf16(v1[0], v1[1]); w.w = cvt_pk_bf16(v1[2], v1[3]);
                    *(u32x4*)(rowp + bj * HALF) = w; } }
    }
};
struct EpiF32Res {
    static constexpr bool PERM = false, AFTER_DRAIN = false;
    const float* base; float* out; int ldc;
    __device__ __forceinline__ void operator()(const f32x4 (&acc)[2][2][4][2], const Unit& u, int wr, int wc, int fr, int fq) const {
        const int col0 = u.pn * BM + wc * 32 + 4 * fq;
#pragma unroll
        for (int ai = 0; ai < 2; ++ai)
#pragma unroll
            for (int m = 0; m < 4; ++m) { const size_t off = (size_t)(u.pm * BM + ai * HALF + wr * 64 + m * 16 + fr) * ldc + col0;
#pragma unroll
                for (int bj = 0; bj < 2; ++bj)
#pragma unroll
                    for (int n = 0; n < 2; ++n) { const f32x4 bs = *(const f32x4*)(base + off + bj * HALF + n * 16); *(f32x4*)(out + off + bj * HALF + n * 16) = bs + acc[ai][bj][m][n]; } }
    }
};
struct EpiSwiglu {
    static constexpr bool PERM = true, AFTER_DRAIN = false;
    bf16_t* O; int ldc; const float* roww;
    __device__ __forceinline__ void operator()(const f32x4 (&acc)[2][2][4][2], const Unit& u, int wr, int wc, int fr, int fq) const {
        const int row0 = u.pm * BM + wr * 64 + fr; const int col0 = u.pn * HALF + wc * 32 + 8 * fq;
#pragma unroll
        for (int ai = 0; ai < 2; ++ai)
#pragma unroll
            for (int m = 0; m < 4; ++m) { const int row = row0 + ai * HALF + m * 16; const float w = roww[row];
                float h[8];
#pragma unroll
                for (int n = 0; n < 2; ++n)
#pragma unroll
                    for (int j = 0; j < 4; ++j) { const float a = acc[ai][0][m][n][j], b = acc[ai][1][m][n][j]; h[n * 4 + j] = a * __builtin_amdgcn_rcpf(1.0f + __expf(-a)) * b * w; }
                u32x4 o; o.x = cvt_pk_bf16(h[0], h[1]); o.y = cvt_pk_bf16(h[2], h[3]); o.z = cvt_pk_bf16(h[4], h[5]); o.w = cvt_pk_bf16(h[6], h[7]);
                *(u32x4*)(O + (size_t)row * ldc + col0) = o; }
    }
};

template <class Epi, class Sched, bool ALIGN_EPI = false, bool SP2 = false>
__device__ __forceinline__ void gemm_phase(PG8_LAS unsigned char* lds, const Gemm g, const Sched& S, const Epi& E) {
    const int tid = otid(), wid = __builtin_amdgcn_readfirstlane(tid >> 6), lane = tid & 63, wr = wid >> 2, wc = wid & 3, fr = lane & 15, fq = lane >> 4;
    const int K = g.K, nt = K / BK;
    unsigned voffB[2]; int RA[2]; unsigned CA2[2];
#pragma unroll
    for (int i = 0; i < 2; ++i) { int R, C; stage_rc(tid * 16 + i * 8192, R, C); const int Rb = Epi::PERM ? ((R & ~31) + perm32(R & 31)) : R;
        RA[i] = R; CA2[i] = (unsigned)C * 2u; voffB[i] = (unsigned)(Rb * K + C) * 2u; }
    unsigned vAc[2][2], vAn[2][2];
#define PG8_MKA(v, u) do { _Pragma("unroll") for (int _h = 0; _h < 2; ++_h) _Pragma("unroll") for (int _i = 0; _i < 2; ++_i) \
        (v)[_h][_i] = (unsigned)S.a_row((u), _h * HALF + RA[_i]) * (unsigned)(K * 2) + CA2[_i]; } while (0)
    const size_t kstep = (size_t)(BK * 2);
    const size_t hstep = (size_t)HALF * K * 2;
    const size_t tstep = 2 * hstep;
    const unsigned ldsw = (unsigned)wid * 1024u;
    const int aoff = lds_byte(wr * 64 + fr, fq * 8), boff = lds_byte(wc * 32 + fr, fq * 8);
#define PG8_SA(b, h) (((b) * 2 + (h)) * HTB)
#define PG8_SB(b, h) ((4 + (b) * 2 + (h)) * HTB)
#define PG8_STAGE(bufoff, gbase, voff) do { _Pragma("unroll") for (int _i = 0; _i < 2; ++_i) \
        __builtin_amdgcn_global_load_lds((const unsigned*)((const char*)(gbase) + (voff)[_i]), (PG8_LAS unsigned*)(lds + (bufoff) + ldsw + _i * 8192), 16, 0, 0); } while (0)
#define PG8_LDA(dst, b, h) do { _Pragma("unroll") for (int m = 0; m < 4; ++m) _Pragma("unroll") for (int k = 0; k < 2; ++k) dst[m][k] = *(const PG8_LAS bf16x8*)(lds + PG8_SA(b, h) + aoff + m * 2048 + k * 1024); } while (0)
#define PG8_LDB(dst, b, h) do { _Pragma("unroll") for (int n = 0; n < 2; ++n) _Pragma("unroll") for (int k = 0; k < 2; ++k) dst[n][k] = *(const PG8_LAS bf16x8*)(lds + PG8_SB(b, h) + boff + n * 2048 + k * 1024); } while (0)
#define PG8_MMA(ai, bj, At, Bt) do { __builtin_amdgcn_s_setprio(1); _Pragma("unroll") for (int m = 0; m < 4; ++m) _Pragma("unroll") for (int n = 0; n < 2; ++n) _Pragma("unroll") for (int k = 0; k < 2; ++k) \
        acc[ai][bj][m][n] = __builtin_amdgcn_mfma_f32_16x16x32_bf16(Bt[n][k], At[m][k], acc[ai][bj][m][n], 0, 0, 0); __builtin_amdgcn_s_setprio(0); } while (0)
#define PG8_WAIT_V(n) asm volatile("s_waitcnt vmcnt(" #n ")" ::: "memory")
#define PG8_WAIT_L(n) asm volatile("s_waitcnt lgkmcnt(" #n ")" ::: "memory")
#define PG8_BAR __builtin_amdgcn_s_barrier()
#define PG8_SCHED __builtin_amdgcn_sched_barrier(0)
    Unit cur, nxt; int ui = 0;
    if (!S.next(0, cur)) return;
    f32x4 acc[2][2][4][2];
#pragma unroll
    for (int a = 0; a < 2; ++a)
#pragma unroll
        for (int b = 0; b < 2; ++b)
#pragma unroll
            for (int m = 0; m < 4; ++m)
#pragma unroll
                for (int n = 0; n < 2; ++n) acc[a][b][m][n] = (f32x4){0.f, 0.f, 0.f, 0.f};
    bf16x8 At[4][2], B0[2][2], B1[2][2];
    const char* const Ab = (const char*)g.A; const char* cB = (const char*)S.b_base(cur, g.Bt) + (size_t)cur.pn * tstep;
    PG8_MKA(vAc, cur);
    S.a_ready(cur);
    if constexpr (SP2) {
        PG8_STAGE(PG8_SB(0, 0), cB, voffB); PG8_STAGE(PG8_SB(0, 1), cB + hstep, voffB); PG8_STAGE(PG8_SA(0, 0), Ab, vAc[0]); PG8_STAGE(PG8_SA(0, 1), Ab, vAc[1]);
        if (wr == 1) PG8_BAR;
        PG8_WAIT_V(2); PG8_BAR;
        PG8_STAGE(PG8_SB(1, 0), cB + kstep, voffB); PG8_STAGE(PG8_SA(1, 0), Ab + kstep, vAc[0]); PG8_STAGE(PG8_SB(1, 1), cB + hstep + kstep, voffB);
        PG8_WAIT_V(6); PG8_BAR;
    }
    for (;;) {
        const bool has_next = S.next(ui + 1, nxt);
        const char* nB = has_next ? (const char*)S.b_base(nxt, g.Bt) + (size_t)nxt.pn * tstep : cB;
        if (has_next) { PG8_MKA(vAn, nxt); } else { _Pragma("unroll") for (int _h = 0; _h < 2; ++_h) _Pragma("unroll") for (int _i = 0; _i < 2; ++_i) vAn[_h][_i] = vAc[_h][_i]; }
        for (int t = 0; t < nt; t += 2) {
            const bool last = (t == nt - 2);
            const char* a1 = Ab + (size_t)(t + 1) * kstep;
            const char* a2 = last ? Ab : Ab + (size_t)(t + 2) * kstep; const char* b2 = last ? nB : cB + (size_t)(t + 2) * kstep;
            unsigned v2[2][2];
            _Pragma("unroll") for (int _h = 0; _h < 2; ++_h) _Pragma("unroll") for (int _i = 0; _i < 2; ++_i) v2[_h][_i] = last ? vAn[_h][_i] : vAc[_h][_i];
            const char* a3 = a2 + kstep; const char* b3 = b2 + kstep;
            if (last && has_next) S.a_ready(nxt);
            if constexpr (SP2) {
            PG8_LDB(B0, 0, 0); PG8_LDB(B1, 0, 1); PG8_SCHED; PG8_LDA(At, 0, 0); PG8_STAGE(PG8_SA(1, 1), a1, vAc[1]);
            PG8_WAIT_V(8); PG8_WAIT_L(0); PG8_BAR; PG8_MMA(0, 0, At, B0); PG8_MMA(0, 1, At, B1); PG8_BAR; PG8_SCHED;
            PG8_LDA(At, 0, 1); PG8_STAGE(PG8_SB(0, 0), b2, voffB); PG8_STAGE(PG8_SB(0, 1), b2 + hstep, voffB); PG8_STAGE(PG8_SA(0, 0), a2, v2[0]);
            PG8_WAIT_V(8); PG8_WAIT_L(0); PG8_BAR; PG8_MMA(1, 0, At, B0); PG8_MMA(1, 1, At, B1); PG8_BAR; PG8_SCHED;
            PG8_LDB(B0, 1, 0); PG8_LDB(B1, 1, 1); PG8_SCHED; PG8_LDA(At, 1, 0); PG8_STAGE(PG8_SA(0, 1), a2, v2[1]);
            PG8_WAIT_V(8); PG8_WAIT_L(0); PG8_BAR; PG8_MMA(0, 0, At, B0); PG8_MMA(0, 1, At, B1); PG8_BAR; PG8_SCHED;
            PG8_LDA(At, 1, 1); PG8_STAGE(PG8_SB(1, 0), b3, voffB); PG8_STAGE(PG8_SB(1, 1), b3 + hstep, voffB); PG8_STAGE(PG8_SA(1, 0), a3, v2[0]);
            PG8_WAIT_V(8); PG8_WAIT_L(0); PG8_BAR; PG8_MMA(1, 0, At, B0); PG8_MMA(1, 1, At, B1); PG8_BAR; PG8_SCHED;
            }
        }
        if constexpr (ALIGN_EPI) { if (wr == 0) PG8_BAR; }
        if constexpr (!Epi::AFTER_DRAIN) { E(acc, cur, wr, wc, fr, fq); S.done(cur); }
        if (!has_next) break;
#pragma unroll
        for (int a = 0; a < 2; ++a)
#pragma unroll
            for (int b = 0; b < 2; ++b)
#pragma unroll
                for (int m = 0; m < 4; ++m)
#pragma unroll
                    for (int n = 0; n < 2; ++n) acc[a][b][m][n] = (f32x4){0.f, 0.f, 0.f, 0.f};
        cur = nxt; cB = nB; ++ui;
        _Pragma("unroll") for (int _h = 0; _h < 2; ++_h) _Pragma("unroll") for (int _i = 0; _i < 2; ++_i) vAc[_h][_i] = vAn[_h][_i];
        if constexpr (ALIGN_EPI) { if (wr == 1) PG8_BAR; }
    }
    PG8_WAIT_V(0);
    if constexpr (!ALIGN_EPI) { if (wr == 0) PG8_BAR; }
    PG8_BAR;
    if constexpr (Epi::AFTER_DRAIN) { E.fused(acc, cur, wr, wc, fr, fq, lds, wid, lane); S.done(cur); }
#undef PG8_SA
#undef PG8_MKA
#undef PG8_SB
#undef PG8_STAGE
#undef PG8_LDA
#undef PG8_LDB
#undef PG8_MMA
#undef PG8_WAIT_V
#undef PG8_WAIT_L
#undef PG8_BAR
#undef PG8_SCHED
}
}

using pg8::bf16_t;
#define LAS __attribute__((address_space(3)))
#define GAS __attribute__((address_space(1)))
typedef unsigned v4u __attribute__((ext_vector_type(4)));
typedef float f32x4 __attribute__((ext_vector_type(4)));
#define LDS_WAIT() asm volatile("s_waitcnt lgkmcnt(0)" ::: "memory")

__device__ __forceinline__ float bf2f(bf16_t u) { return __uint_as_float((unsigned)u << 16); }
__device__ __forceinline__ unsigned f2bf(float f) { unsigned u = __float_as_uint(f); return (u + 0x7fffu + ((u >> 16) & 1u)) >> 16; }
__device__ __forceinline__ unsigned pk2(float lo, float hi) { return f2bf(lo) | (f2bf(hi) << 16); }

template <int CTRL> __device__ __forceinline__ float dpp_mov(float v) { return __builtin_bit_cast(float, __builtin_amdgcn_update_dpp(0, __builtin_bit_cast(int, v), CTRL, 0xf, 0xf, true)); }
__device__ __forceinline__ float row_sum16(float v) { v += dpp_mov<0xB1>(v); v += dpp_mov<0x4E>(v); v += dpp_mov<0x141>(v); v += dpp_mov<0x140>(v); return v; }
__device__ __forceinline__ float rdlane(float v, int l) { return __builtin_bit_cast(float, __builtin_amdgcn_readlane(__builtin_bit_cast(int, v), l)); }
__device__ __forceinline__ float wave_sum(float v) {
    v = row_sum16(v);
    return (rdlane(v, 0) + rdlane(v, 16)) + (rdlane(v, 32) + rdlane(v, 48));
}
__device__ __forceinline__ float wave_max(float v) {
#pragma unroll
    for (int o = 1; o < 64; o <<= 1) v = fmaxf(v, __shfl_xor(v, o));
    return v;
}
__device__ __forceinline__ float block_sum(float v, float* red, int tid) {
    v = wave_sum(v);
    __syncthreads();
    if ((tid & 63) == 0) red[tid >> 6] = v;
    __syncthreads();
    return red[0] + red[1] + red[2] + red[3];
}
__device__ __forceinline__ float block_max(float v, float* red, int tid) {
    v = wave_max(v);
    __syncthreads();
    if ((tid & 63) == 0) red[tid >> 6] = v;
    __syncthreads();
    return fmaxf(fmaxf(red[0], red[1]), fmaxf(red[2], red[3]));
}
__device__ __forceinline__ unsigned fkey(float f) {
    unsigned u = __float_as_uint(f);
    return (u & 0x80000000u) ? ~u : (u | 0x80000000u);
}

__device__ __forceinline__ void p0_transpose_item(const float* W, int K, int N, int k0, int n0, bf16_t* WT, int orow0, LAS float* scr, int lane) {
    const int ncol = n0 + (lane & 31);
#pragma unroll 8
    for (int i = 0; i < 32; ++i) { const int kk = 2 * i + (lane >> 5); scr[kk * 33 + (lane & 31)] = (ncol < N) ? W[(size_t)(k0 + kk) * N + ncol] : 0.f; }
    LDS_WAIT(); asm volatile("" ::: "memory");
    const int c = lane & 7;
#pragma unroll
    for (int j = 0; j < 4; ++j) { const int n = (lane >> 3) + 8 * j; const LAS float* sp = scr + (8 * c) * 33 + n;
        v4u o; o.x = pk2(sp[0 * 33], sp[1 * 33]); o.y = pk2(sp[2 * 33], sp[3 * 33]); o.z = pk2(sp[4 * 33], sp[5 * 33]); o.w = pk2(sp[6 * 33], sp[7 * 33]);
        *(GAS v4u*)(WT + (size_t)(orow0 + n) * K + k0 + 8 * c) = o; }
    LDS_WAIT(); asm volatile("" ::: "memory");
}
__device__ __forceinline__ void rms_row_to_bf16(const float* xrow, const float* g, bf16_t* orow, int lane) {
    const GAS f32x4* xr = (const GAS f32x4*)xrow + lane;
    const GAS f32x4* gr = (const GAS f32x4*)g + lane;
    f32x4 v[8]; float s = 0.f;
#pragma unroll
    for (int j = 0; j < 8; ++j) { v[j] = xr[64 * j]; s += (v[j].x * v[j].x + v[j].y * v[j].y) + (v[j].z * v[j].z + v[j].w * v[j].w); }
    const float rstd = rsqrtf(wave_sum(s) * (1.f / D) + EPS);
    GAS unsigned long long* o8 = (GAS unsigned long long*)orow + lane;
#pragma unroll
    for (int j = 0; j < 8; ++j) { const f32x4 gg = gr[64 * j];
        o8[64 * j] = (unsigned long long)pk2(v[j].x * rstd * gg.x, v[j].y * rstd * gg.y) | ((unsigned long long)pk2(v[j].z * rstd * gg.z, v[j].w * rstd * gg.w) << 32); }
}

__device__ __forceinline__ void nv_gemm_tile(bool active, int m0, int n0, int tid, float* sm, const float* A, int lda, const float* Bm, int ldb, float* C, int ldc,
                                             int N, int K, const float* R, int ldr) {
    float* As = sm;
    float* Bs = sm + 16 * 65;
    const int tx = tid & 15, ty = tid >> 4;
    float acc[4][4];
#pragma unroll
    for (int i = 0; i < 4; ++i)
#pragma unroll
        for (int j = 0; j < 4; ++j) acc[i][j] = 0.f;
    for (int k0 = 0; k0 < K; k0 += 16) {
        if (active) {
#pragma unroll
            for (int q = 0; q < 4; ++q) { int i = tid + 256 * q; int r = i >> 4, c = i & 15; As[c * 65 + r] = A[(size_t)(m0 + r) * lda + k0 + c]; }
#pragma unroll
            for (int q = 0; q < 4; ++q) { int i = tid + 256 * q; int r = i >> 6, c = i & 63; int n = n0 + c; Bs[r * 64 + c] = (n < N) ? Bm[(size_t)(k0 + r) * ldb + n] : 0.f; }
        }
        __syncthreads();
        if (active) {
#pragma unroll
            for (int kk = 0; kk < 16; ++kk) {
                float a[4], b[4];
#pragma unroll
                for (int i = 0; i < 4; ++i) a[i] = As[kk * 65 + ty * 4 + i];
#pragma unroll
                for (int j = 0; j < 4; ++j) b[j] = Bs[kk * 64 + tx * 4 + j];
#pragma unroll
                for (int i = 0; i < 4; ++i)
#pragma unroll
                    for (int j = 0; j < 4; ++j) acc[i][j] += a[i] * b[j];
            }
        }
        __syncthreads();
    }
    if (active) {
#pragma unroll
        for (int i = 0; i < 4; ++i)
#pragma unroll
            for (int j = 0; j < 4; ++j) {
                int m = m0 + ty * 4 + i, n = n0 + tx * 4 + j;
                if (n < N) { float v = acc[i][j]; if (R) v += R[(size_t)m * ldr + n]; C[(size_t)m * ldc + n] = v; }
            }
    }
}
__device__ __forceinline__ void nv_gemm_phase(int sub, int tid, float* sm, const float* A, int lda, const float* Bm, int ldb, float* C, int ldc,
                                              int M, int N, int K, const float* R, int ldr, const int* tile_e, size_t strideB) {
    const int ntn = (N + 63) / 64, ntm = M / 64, total = ntn * ntm;
    const int nsb = gridDim.x * 2, iters = (total + nsb - 1) / nsb;
    for (int it = 0; it < iters; ++it) {
        const int tile = (it * gridDim.x + blockIdx.x) * 2 + sub;
        bool active = tile < total;
        const int mt = active ? tile / ntn : 0, nt = active ? tile % ntn : 0;
        const float* Bp = Bm;
        if (tile_e && active) { const int e = tile_e[mt]; if (e < 0) active = false; else Bp = Bm + (size_t)e * strideB; }
        nv_gemm_tile(active, mt * 64, nt * 64, tid, sm, A, lda, Bp, ldb, C, ldc, N, K, R, ldr);
    }
}

__device__ __forceinline__ void nv_postproj(int t, int tid, bf16_t* pb, float* iwf, bf16_t* ikc, const float* qg, const float* kg, const float* lnw, const float* lnb, const float2* rot) {
    const int tl = t & (S - 1);
    bf16_t* p = pb + (size_t)t * LDP;
    const int w = tid >> 6, lane = tid & 63;
    for (int h = w; h < 8; h += 4) {
        bf16_t* q = p + OQ + h * 128; float a = bf2f(q[lane]), b = bf2f(q[lane + 64]);
        float ss = wave_sum(a * a + b * b); float r = rsqrtf(ss * (1.0f / 128) + EPS);
        q[lane] = (bf16_t)f2bf(a * r * qg[lane]); q[lane + 64] = (bf16_t)f2bf(b * r * qg[lane + 64]);
    }
    if (w < 2) {
        bf16_t* q = p + OKK + w * 128; float a = bf2f(q[lane]), b = bf2f(q[lane + 64]);
        float ss = wave_sum(a * a + b * b); float r = rsqrtf(ss * (1.0f / 128) + EPS);
        q[lane] = (bf16_t)f2bf(a * r * kg[lane]); q[lane + 64] = (bf16_t)f2bf(b * r * kg[lane + 64]);
    }
    if (w == 2) {
        float v = bf2f(p[OIK + lane]); float mean = wave_sum(v) * (1.0f / 64); float d = v - mean;
        float var = wave_sum(d * d) * (1.0f / 64);
        const bf16_t kb = (bf16_t)f2bf(d * rsqrtf(var + EPS) * lnw[lane] + lnb[lane]);
        p[OIK + lane] = kb; ikc[(size_t)t * 64 + lane] = kb;
    }
    if (w == 3 && lane < 16) iwf[t * 16 + lane] = bf2f(p[OIW + lane]) * 0.03125f;
    for (int it = w; it < 16; it += 4) {
        const int which = it >> 3, h = it & 7;
        bf16_t* r = p + (which ? ORK : ORQ) + h * 128;
        const float2 cs = rot[tl * 64 + lane];
        const float x1 = bf2f(r[lane]), x2 = bf2f(r[lane + 64]);
        const float sc = which ? 0.08838834764831845f : 1.f;
        r[lane] = (bf16_t)f2bf((x1 * cs.x - x2 * cs.y) * sc); r[lane + 64] = (bf16_t)f2bf((x1 * cs.y + x2 * cs.x) * sc);
    }
}

typedef short bf16x8_t __attribute__((ext_vector_type(8)));
typedef float f32x16_t __attribute__((ext_vector_type(16)));
constexpr int IDX_PITCH = 144, IDX_BUF = 128 * IDX_PITCH;
__device__ __forceinline__ int half_sum32(int c, int hi) {
    c += __builtin_amdgcn_update_dpp(0, c, 0xB1, 0xf, 0xf, true); c += __builtin_amdgcn_update_dpp(0, c, 0x4E, 0xf, 0xf, true);
    c += __builtin_amdgcn_update_dpp(0, c, 0x141, 0xf, 0xf, true); c += __builtin_amdgcn_update_dpp(0, c, 0x140, 0xf, 0xf, true);
    const int lo = __builtin_amdgcn_readlane(c, 0) + __builtin_amdgcn_readlane(c, 16), hi_ = __builtin_amdgcn_readlane(c, 32) + __builtin_amdgcn_readlane(c, 48);
    return hi ? hi_ : lo;
}
__device__ __forceinline__ void idx_unit(int u, int T_, const bf16_t* pb, const bf16_t* ikc, const float* iwf, unsigned long long* maskw, LAS char* lds) {
    const int lane = T_ & 63, wave = T_ >> 6, r32 = lane & 31, hi = lane >> 5;
    const int t0 = u * 16 + wave * 2;
    const int tl0 = t0 & (S - 1), b0 = t0 - tl0, bidx = t0 / S;
    const int nvis = 64 * (tl0 / 64 + 1), ntile = nvis / 32, nblk = (nvis + 127) / 128;
    const bf16_t* sbase = ikc + (size_t)b0 * 64 + (size_t)T_ * 8;
    const int soff0 = (T_ >> 3) * IDX_PITCH + (T_ & 7) * 16, soff1 = soff0 + 64 * IDX_PITCH;
    v4u st0 = *(const v4u*)sbase, st1 = *(const v4u*)(sbase + 4096);
    bf16x8_t af[4];
    { const bf16_t* ap = pb + (size_t)(t0 + (r32 >> 4)) * LDP + OIQ + (r32 & 15) * 64 + hi * 8;
#pragma unroll
      for (int ks = 0; ks < 4; ++ks) af[ks] = *(const bf16x8_t*)(ap + ks * 16); }
    float w0r[8], w1r[8];
#pragma unroll
    for (int r = 0; r < 8; ++r) { const int h = (r & 3) + 8 * (r >> 2) + 4 * hi; w0r[r] = iwf[(size_t)t0 * 16 + h]; w1r[r] = iwf[(size_t)(t0 + 1) * 16 + h]; }
    unsigned key[64];
#pragma unroll
    for (int j = 0; j < 64; ++j) key[j] = 0u;
    *(LAS v4u*)(lds + soff0) = st0; *(LAS v4u*)(lds + soff1) = st1;
    __syncthreads();
#pragma unroll
    for (int blk = 0; blk < 16; ++blk) {
        if (blk < nblk) {
            const bool more = blk + 1 < nblk;
            if (more) { st0 = *(const v4u*)(sbase + (size_t)(blk + 1) * 8192); st1 = *(const v4u*)(sbase + (size_t)(blk + 1) * 8192 + 4096); }
            const LAS char* buf = lds + (blk & 1) * IDX_BUF + r32 * IDX_PITCH + hi * 16;
#pragma unroll
            for (int tt = 0; tt < 4; ++tt) {
                if (4 * blk + tt < ntile) {
                    f32x16_t acc = {};
#pragma unroll
                    for (int ks = 0; ks < 4; ++ks) { const bf16x8_t bfr = *(const LAS bf16x8_t*)(buf + tt * 32 * IDX_PITCH + ks * 32); acc = __builtin_amdgcn_mfma_f32_32x32x16_bf16(af[ks], bfr, acc, 0, 0, 0); }
                    float p0 = 0.f, p1 = 0.f;
#pragma unroll
                    for (int r = 0; r < 8; ++r) { p0 += fmaxf(acc[r], 0.f) * w0r[r]; p1 += fmaxf(acc[8 + r], 0.f) * w1r[r]; }
                    auto rr = __builtin_amdgcn_permlane32_swap(__float_as_uint(p0), __float_as_uint(p1), false, false);
                    const float sc = __uint_as_float(rr[0]) + __uint_as_float(rr[1]);
                    key[4 * blk + tt] = fkey(sc);
                }
            }
            if (more) { *(LAS v4u*)(lds + ((blk + 1) & 1) * IDX_BUF + soff0) = st0; *(LAS v4u*)(lds + ((blk + 1) & 1) * IDX_BUF + soff1) = st1; }
            __syncthreads();
        }
    }
    unsigned T = 1u;
    if (nvis > 256) {
        T = 0u; bool done = false;
        for (int bit = 31; bit >= 0; --bit) {
            const unsigned cand = T | (1u << bit);
            int c = 0;
#pragma unroll
            for (int blk = 0; blk < 16; ++blk) if (blk < nblk) {
#pragma unroll
                for (int tt = 0; tt < 4; ++tt) c += (key[4 * blk + tt] >= cand) ? 1 : 0; }
            c = half_sum32(c, hi);
            if (!done && c >= 256) T = cand;
            if (c == 256) done = true;
            if (__all(done)) break;
        }
    }
    unsigned w0lo = 0u, w0hi = 0u, w1lo = 0u, w1hi = 0u;
#pragma unroll
    for (int J = 0; J < 32; ++J) {
        const unsigned long long ma = __ballot(key[2 * J] >= T), mb = __ballot(key[2 * J + 1] >= T);
        if (lane == J) { w0lo = (unsigned)ma; w0hi = (unsigned)mb; w1lo = (unsigned)(ma >> 32); w1hi = (unsigned)(mb >> 32); }
    }
    if (lane < 32) {
        unsigned long long* mp = maskw + ((size_t)(bidx * 32 + lane)) * S + tl0;
        mp[0] = ((unsigned long long)w0hi << 32) | w0lo;
        mp[1] = ((unsigned long long)w1hi << 32) | w1lo;
    }
}

__device__ __forceinline__ void nv_attn(int t, int tid, float* sm, const bf16_t* pb, const unsigned long long* maskw, bf16_t* cat) {
    float* red = sm; float* sq = sm + 16; float* sc = sm + 16 + 512;
    const int tl = t & (S - 1), b0 = t - tl;
    const int nvis = 64 * (tl / 64 + 1);
    const bf16_t* p = pb + (size_t)t * LDP;
    for (int g = 0; g < 2; ++g) {
        __syncthreads();
        for (int i = tid; i < 512; i += 256) sq[i] = bf2f(p[OQ + g * 512 + i]);
        __syncthreads();
        for (int s = tid; s < nvis; s += 256) {
            const bool sel = (maskw[((size_t)((t / S) * 32 + (s >> 6))) * S + tl] >> (s & 63)) & 1ull;
            float d0 = -INFINITY, d1 = -INFINITY, d2 = -INFINITY, d3 = -INFINITY;
            if (sel) {
                const bf16_t* kp = pb + (size_t)(b0 + s) * LDP + OKK + g * 128;
                d0 = d1 = d2 = d3 = 0.f;
                for (int d = 0; d < 128; ++d) { const float kv = bf2f(kp[d]); d0 += sq[d] * kv; d1 += sq[128 + d] * kv; d2 += sq[256 + d] * kv; d3 += sq[384 + d] * kv; }
                const float scl = 0.08838834764831845f;
                d0 *= scl; d1 *= scl; d2 *= scl; d3 *= scl;
            }
            sc[s] = d0; sc[2048 + s] = d1; sc[4096 + s] = d2; sc[6144 + s] = d3;
        }
        __syncthreads();
        float inv[4];
#pragma unroll
        for (int hh = 0; hh < 4; ++hh) {
            float m = -INFINITY;
            for (int s = tid; s < nvis; s += 256) m = fmaxf(m, sc[hh * 2048 + s]);
            m = block_max(m, red, tid);
            float sum = 0.f;
            for (int s = tid; s < nvis; s += 256) { const float v = sc[hh * 2048 + s]; const float e = (v == -INFINITY) ? 0.f : expf(v - m); sc[hh * 2048 + s] = e; sum += e; }
            sum = block_sum(sum, red, tid);
            inv[hh] = 1.0f / sum;
        }
        __syncthreads();
        const int d = tid & 127, half = tid >> 7;
#pragma unroll
        for (int rep = 0; rep < 2; ++rep) {
            const int hh = half + 2 * rep;
            float acc = 0.f;
            for (int s = 0; s < nvis; ++s) {
                const float pe = sc[hh * 2048 + s];
                if (pe != 0.f) acc += pe * bf2f(pb[(size_t)(b0 + s) * LDP + OV + g * 128 + d]);
            }
            cat[(size_t)t * D + (g * 4 + hh) * 128 + d] = (bf16_t)f2bf(acc * (half == 0 ? (rep == 0 ? inv[0] : inv[2]) : (rep == 0 ? inv[1] : inv[3])));
        }
    }
}

__device__ __forceinline__ void nv_ret(int t, int tid, float* sm, const bf16_t* pb, const float* rng, bf16_t* cat) {
    float* red = sm; float* sq = sm + 16; float* comb = sm + 16 + 128; float* sw = sm + 16 + 128 + 256;
    const int tl = t & (S - 1), b0 = t - tl;
    const bf16_t* p = pb + (size_t)t * LDP;
    for (int h = 0; h < 8; ++h) {
        __syncthreads();
        if (tid < 128) sq[tid] = bf2f(p[ORQ + h * 128 + tid]);
        __syncthreads();
        const float lg = log1pf(-exp2f(-5.0f - (float)h));
        for (int m = tid; m <= tl; m += 256) {
            const bf16_t* kp = pb + (size_t)(b0 + m) * LDP + ORK + h * 128;
            float dot = 0.f;
            for (int d = 0; d < 128; ++d) dot += sq[d] * bf2f(kp[d]);
            sw[m] = dot * expf(lg * (float)(tl - m));
        }
        __syncthreads();
        const int e = tid & 127, half = tid >> 7;
        float acc = 0.f;
        for (int m = half; m <= tl; m += 2) acc += sw[m] * bf2f(pb[(size_t)(b0 + m) * LDP + ORV + h * 128 + e]);
        comb[tid] = acc;
        __syncthreads();
        float o = comb[e] + comb[e + 128];
        float ss = block_sum(half == 0 ? o * o : 0.f, red, tid);
        if (half == 0) {
            const float y = o * rsqrtf(ss * (1.0f / 128) + EPS) * rng[h * 128 + e];
            const float gt = bf2f(p[ORG + h * 128 + e]);
            cat[(size_t)t * D + 1024 + h * 128 + e] = (bf16_t)f2bf(gt / (1.0f + expf(-gt)) * y);
        }
    }
}

__device__ __forceinline__ void nv_router(int t, int tid, float* sm, const float* x1, const float* g2, const float* wg, const float* wr, bf16_t* h2, int* eid, float* ew, int* cnt) {
    float* red = sm; float* lg = sm + 16;
    float v[8], ss = 0.f;
#pragma unroll
    for (int j = 0; j < 8; ++j) { v[j] = x1[(size_t)t * D + tid + 256 * j]; ss += v[j] * v[j]; }
    ss = block_sum(ss, red, tid);
    const float r = rsqrtf(ss * (1.0f / D) + EPS);
#pragma unroll
    for (int j = 0; j < 8; ++j) { v[j] = v[j] * r * g2[tid + 256 * j]; h2[(size_t)t * D + tid + 256 * j] = (bf16_t)f2bf(v[j]); }
    for (int c = 0; c < 36; ++c) {
        float pa = 0.f;
#pragma unroll
        for (int j = 0; j < 8; ++j) {
            const int d = tid + 256 * j;
            const float w = (c < 4) ? wg[d * 4 + c] : wr[((size_t)((c - 4) >> 3) * D + d) * 8 + ((c - 4) & 7)];
            pa += v[j] * w;
        }
        pa = block_sum(pa, red, tid);
        if (tid == 0) lg[c] = pa;
    }
    __syncthreads();
    if (tid == 0) {
        int gs = 0; for (int c = 1; c < 4; ++c) if (lg[c] > lg[gs]) gs = c;
        float den = 0.f; for (int c = 0; c < 4; ++c) den += expf(lg[c] - lg[gs]);
        const float gate = 1.0f / den;
        const float* el = lg + 4 + gs * 8;
        int i0 = 0; for (int c = 1; c < 8; ++c) if (el[c] > el[i0]) i0 = c;
        int i1 = -1; for (int c = 0; c < 8; ++c) if (c != i0 && (i1 < 0 || el[c] > el[i1])) i1 = c;
        const float e1 = expf(el[i1] - el[i0]);
        const float w0 = 1.0f / (1.0f + e1) * gate, w1 = e1 / (1.0f + e1) * gate;
        eid[t * 2] = gs * 8 + i0; eid[t * 2 + 1] = gs * 8 + i1; ew[t * 2] = w0; ew[t * 2 + 1] = w1;
        atomicAdd(&cnt[gs * 8 + i0], 1); atomicAdd(&cnt[gs * 8 + i1], 1);
    }
}

__device__ __forceinline__ void nv_fill(int t, int tid, float* sm, const int* soff, const bf16_t* h2, const int* eid, const float* ew, int* fill, int* slot_of, float* slotw, bf16_t* xg) {
    int* sslot = (int*)sm;
    __syncthreads();
    if (tid < 2) {
        const int e = eid[t * 2 + tid];
        const int slot = soff[e] + atomicAdd(&fill[e], 1);
        sslot[tid] = slot; slot_of[t * 2 + tid] = slot; slotw[slot] = ew[t * 2 + tid];
    }
    __syncthreads();
    const v4u v = *(const v4u*)(h2 + (size_t)t * D + tid * 8);
    *(v4u*)(xg + (size_t)sslot[0] * D + tid * 8) = v;
    *(v4u*)(xg + (size_t)sslot[1] * D + tid * 8) = v;
}

namespace att {
using bf16x8 = __attribute__((ext_vector_type(8))) short;
using s16x4  = __attribute__((ext_vector_type(4))) short;
using f32x16 = __attribute__((ext_vector_type(16))) float;
using u32x4  = __attribute__((ext_vector_type(4))) unsigned;
constexpr int   D = 128, NW = 8, QBLK = 32, KVBLK = 64;
constexpr float SCALE = 0.088388347648318440f;
constexpr float THR = 8.f;
constexpr size_t SHM_V = KVBLK * D * 2, SHM_K = KVBLK * D * 2, SHM_ATTN = 2 * SHM_V + 2 * SHM_K + NW * 64 * 4;
#define KSWZ(row, colB) ((row) * 256 + ((colB) ^ (((row) & 7) << 4)))
#define SBAR() __builtin_amdgcn_sched_barrier(0)
__device__ __forceinline__ int crow(int r, int hi) { return (r & 3) + 8 * (r >> 2) + 4 * hi; }
__device__ __forceinline__ unsigned cvtpk(float lo, float hi) {
  unsigned r; asm volatile("v_cvt_pk_bf16_f32 %0, %1, %2" : "=v"(r) : "v"(lo), "v"(hi)); return r;
}
__device__ __forceinline__ void partialSM(f32x16& p0, f32x16& p1, float& m_reg, float& mn, float& alpha) {
  constexpr float C = SCALE * 1.4426950408889634f;
  float pmax = p0[0]; for (int r = 1; r < 16; ++r) pmax = fmaxf(pmax, p0[r]); for (int r = 0; r < 16; ++r) pmax = fmaxf(pmax, p1[r]);
  { auto rr = __builtin_amdgcn_permlane32_swap(__float_as_uint(pmax), __float_as_uint(pmax), false, false);
    pmax = fmaxf(__uint_as_float(rr[0]), __uint_as_float(rr[1])); }
  if (__builtin_expect(__all(pmax - m_reg <= THR / SCALE), 1)) { mn = m_reg; alpha = 1.f; }
  else { mn = fmaxf(m_reg, pmax); alpha = __builtin_amdgcn_exp2f((m_reg - mn) * C); m_reg = mn; }
  float mnC = -mn * C;
  for (int r = 0; r < 16; ++r) p0[r] = fmaf(p0[r], C, mnC); for (int r = 0; r < 16; ++r) p1[r] = fmaf(p1[r], C, mnC);
  for (int r = 0; r < 16; ++r) p0[r] = __builtin_amdgcn_exp2f(p0[r]);
}
__device__ __forceinline__ void finishSM(f32x16& p0, f32x16& p1, float alpha, float& l_reg, bf16x8& pa0, bf16x8& pa1, bf16x8& pa2, bf16x8& pa3) {
  for (int r = 0; r < 16; ++r) p1[r] = __builtin_amdgcn_exp2f(p1[r]);
  float ps = 0; for (int r = 0; r < 16; ++r) ps += p0[r]; for (int r = 0; r < 16; ++r) ps += p1[r];
  { auto rr = __builtin_amdgcn_permlane32_swap(__float_as_uint(ps), __float_as_uint(ps), false, false);
    ps = __uint_as_float(rr[0]) + __uint_as_float(rr[1]); }
  l_reg = l_reg * alpha + ps;
#define PK4(P, BASE, OUT) do { unsigned a0 = cvtpk(P[BASE + 0], P[BASE + 1]), a1 = cvtpk(P[BASE + 2], P[BASE + 3]);   \
    unsigned b0 = cvtpk(P[BASE + 4], P[BASE + 5]), b1 = cvtpk(P[BASE + 6], P[BASE + 7]);                              \
    auto r0 = __builtin_amdgcn_permlane32_swap(a0, b0, false, false); auto r1 = __builtin_amdgcn_permlane32_swap(a1, b1, false, false); \
    u32x4 w = {r0[0], r1[0], r0[1], r1[1]}; OUT = *reinterpret_cast<bf16x8*>(&w); } while (0)
  PK4(p0, 0, pa0); PK4(p0, 8, pa1); PK4(p1, 0, pa2); PK4(p1, 8, pa3);
#undef PK4
}
__device__ __forceinline__ void qkt(f32x16& p0, f32x16& p1, const bf16_t* Ks, const bf16x8* qr, int r32, int hi) {
  p0 = f32x16{}; p1 = f32x16{};
  for (int d0 = 0; d0 < 8; ++d0) { int cb = (d0 * 16 + hi * 8) * 2;
    bf16x8 b0 = *reinterpret_cast<const bf16x8*>((const char*)Ks + KSWZ(r32, cb));
    bf16x8 b1 = *reinterpret_cast<const bf16x8*>((const char*)Ks + KSWZ(32 + r32, cb));
    p0 = __builtin_amdgcn_mfma_f32_32x32x16_bf16(b0, qr[d0], p0, 0, 0, 0);
    p1 = __builtin_amdgcn_mfma_f32_32x32x16_bf16(b1, qr[d0], p1, 0, 0, 0); }
}
__device__ __forceinline__ int v_st(int k, int c) { const int kk = (k & ~0xC) | ((k & 4) << 1) | ((k & 8) >> 1); return ((kk >> 3) * 4 + (c >> 5)) * 512 + ((kk & 7) * 32 + (c & 31)) * 2; }
__device__ __forceinline__ int v_rd_base(int lane) { return ((lane & 3) << 3) | (((lane >> 2) & 3) << 6) | (((lane >> 4) & 1) << 5) | (((lane >> 5) & 1) << 8); }
constexpr int v_rd_off(int d0, int ks, int half) { return d0 * 512 + ks * 4096 + half * 2048; }
template <int OFF> __device__ __forceinline__ s16x4 tr_read(int vb) {
  s16x4 r; asm volatile("ds_read_b64_tr_b16 %0, %1 offset:%2" : "=&v"(r) : "v"(vb), "i"(OFF) : "memory"); return r;
}
template <int D0> __device__ __forceinline__ void pv_one(f32x16& od, int vb, bf16x8 pa0, bf16x8 pa1, bf16x8 pa2, bf16x8 pa3) {
  const s16x4 l0 = tr_read<v_rd_off(D0, 0, 0)>(vb), h0 = tr_read<v_rd_off(D0, 0, 1)>(vb), l1 = tr_read<v_rd_off(D0, 1, 0)>(vb), h1 = tr_read<v_rd_off(D0, 1, 1)>(vb);
  const s16x4 l2 = tr_read<v_rd_off(D0, 2, 0)>(vb), h2 = tr_read<v_rd_off(D0, 2, 1)>(vb), l3 = tr_read<v_rd_off(D0, 3, 0)>(vb), h3 = tr_read<v_rd_off(D0, 3, 1)>(vb);
  asm volatile("s_waitcnt lgkmcnt(0)" ::: "memory"); SBAR();
#define PK(L, H) (bf16x8){L[0], L[1], L[2], L[3], H[0], H[1], H[2], H[3]}
  od = __builtin_amdgcn_mfma_f32_32x32x16_bf16(pa0, PK(l0, h0), od, 0, 0, 0);
  od = __builtin_amdgcn_mfma_f32_32x32x16_bf16(pa1, PK(l1, h1), od, 0, 0, 0);
  od = __builtin_amdgcn_mfma_f32_32x32x16_bf16(pa2, PK(l2, h2), od, 0, 0, 0);
  od = __builtin_amdgcn_mfma_f32_32x32x16_bf16(pa3, PK(l3, h3), od, 0, 0, 0);
#undef PK
}
__device__ __forceinline__ void pv_d0(f32x16* o, int vb, bf16x8 pa0, bf16x8 pa1, bf16x8 pa2, bf16x8 pa3) {
  pv_one<0>(o[0], vb, pa0, pa1, pa2, pa3); pv_one<1>(o[1], vb, pa0, pa1, pa2, pa3); pv_one<2>(o[2], vb, pa0, pa1, pa2, pa3); pv_one<3>(o[3], vb, pa0, pa1, pa2, pa3);
}

__device__ __forceinline__ void apply_mask(f32x16& p0, f32x16& p1, unsigned lo, unsigned hi_) {
#pragma unroll
  for (int r = 0; r < 16; ++r) { const unsigned bit = 1u << ((r & 3) + 8 * (r >> 2));
    p0[r] = (lo & bit) ? p0[r] : -INFINITY; p1[r] = (hi_ & bit) ? p1[r] : -INFINITY; }
}
template <int LDQ, int LDK, int LDO, int MSTR>
__device__ __forceinline__ void att_unit(const bf16_t* __restrict__ Qw0, const bf16_t* __restrict__ Kh, const bf16_t* __restrict__ Vh, bf16_t* __restrict__ Ow0,
                                         const unsigned long long* __restrict__ mw0, int my_nt, int NT, char* lds) {
  const int tid = otid(), wid = tid >> 6, lane = tid & 63, r32 = lane & 31, hi = lane >> 5;
  bf16_t* V_lds = (bf16_t*)lds; bf16_t* K_lds = (bf16_t*)(lds + 2 * SHM_V);
  float* ws = (float*)(lds + 2 * SHM_V + 2 * SHM_K) + wid * 64; float* li_l = ws; float* al_l = ws + 32;
  float m_reg = -1e30f, l_reg = 0; f32x16 o[4] = {}; bf16x8 qr[8];
  const bf16_t* Qw = Qw0 + (long)r32 * LDQ + hi * 8;
#pragma unroll
  for (int d0 = 0; d0 < 8; ++d0) qr[d0] = *reinterpret_cast<const bf16x8*>(Qw + d0 * 16);
  const unsigned long long* mq = mw0 + r32;
  const int sr = tid >> 4, sc = (tid & 15) * 8, vst0 = v_st(sr, sc), vst1 = v_st(32 + sr, sc);
  const int vb0 = (int)(uintptr_t)V_lds + v_rd_base(lane);
  constexpr int SDEPTH = 1, SE = 0, SO = SDEPTH - 1;
  struct { bf16x8 vs0, vs1, ks0, ks1; } sr_[SDEPTH];
#define SLOAD(i, k0) do { sr_[i].vs0 = *reinterpret_cast<const bf16x8*>(&Vh[(long)((k0) + sr) * LDK + sc]); sr_[i].vs1 = *reinterpret_cast<const bf16x8*>(&Vh[(long)((k0) + 32 + sr) * LDK + sc]); \
    sr_[i].ks0 = *reinterpret_cast<const bf16x8*>(&Kh[(long)((k0) + sr) * LDK + sc]); sr_[i].ks1 = *reinterpret_cast<const bf16x8*>(&Kh[(long)((k0) + 32 + sr) * LDK + sc]); } while (0)
#define SWRITE(b, i) do { *(bf16x8*)((char*)V_lds + (b) * SHM_V + vst0) = sr_[i].vs0;          \
    *(bf16x8*)((char*)V_lds + (b) * SHM_V + vst1) = sr_[i].vs1; int kc = sc * 2;               \
    *(bf16x8*)((char*)K_lds + (b) * SHM_K + KSWZ(sr, kc)) = sr_[i].ks0;                       \
    *(bf16x8*)((char*)K_lds + (b) * SHM_K + KSWZ(32 + sr, kc)) = sr_[i].ks1; } while (0)
#define SWAIT() do { if constexpr (SDEPTH == 2) asm volatile("s_waitcnt vmcnt(4)" ::: "memory"); else asm volatile("s_waitcnt vmcnt(0)" ::: "memory"); } while (0)
#define RESC(a) do { if (__any((a) < 1.f)) { if (hi == 0) al_l[r32] = (a); asm volatile("s_waitcnt lgkmcnt(0)" ::: "memory"); \
    for (int d = 0; d < 4; ++d) for (int r = 0; r < 16; ++r) o[d][r] *= al_l[crow(r, hi)]; } } while (0)
#define MLOAD(j) (mq[(long)(j) * MSTR])
#define MASK(P0, P1, mw) apply_mask(P0, P1, (unsigned)(mw) >> (4 * hi), (unsigned)((mw) >> 32) >> (4 * hi))
  f32x16 p0, p1; float mn, al; bf16x8 pa0, pa1, pa2, pa3;
  unsigned long long mw;
  SLOAD(SE, 0); mw = MLOAD(0); asm volatile("s_waitcnt vmcnt(0)" ::: "memory"); SWRITE(0, SE); __syncthreads();
  for (int j = 0; j < NT; ++j) {
    const int cur = j & 1; const bool more = (j + 1 < NT);
    if (more) SLOAD(SE, (j + 1) * KVBLK);
    if (j < my_nt) {
      SBAR(); qkt(p0, p1, (bf16_t*)((char*)K_lds + cur * SHM_K), qr, r32, hi);
      MASK(p0, p1, mw); if (j + 1 < my_nt) mw = MLOAD(j + 1);
      partialSM(p0, p1, m_reg, mn, al);
      RESC(al);
      finishSM(p0, p1, al, l_reg, pa0, pa1, pa2, pa3); SBAR();
      pv_d0(o, vb0 + cur * (int)SHM_V, pa0, pa1, pa2, pa3);
    }
    if (more) { SWAIT(); SWRITE(cur ^ 1, SE); }
    __syncthreads();
  }
  if (hi == 0) li_l[r32] = l_reg; asm volatile("s_waitcnt lgkmcnt(0)" ::: "memory");
  float rli[16];
#pragma unroll
  for (int r = 0; r < 16; ++r) rli[r] = __builtin_amdgcn_rcpf(li_l[crow(r, hi)]);
  bf16_t* Ow = Ow0;
#pragma unroll
  for (int r = 0; r < 16; ++r) { const int orow = crow(r, hi);
#pragma unroll
    for (int d0 = 0; d0 < 4; ++d0) Ow[(long)orow * LDO + d0 * 32 + r32] = (bf16_t)f2bf(o[d0][r] * rli[r]); }
  __syncthreads();
#undef SLOAD
#undef SWRITE
#undef SWAIT
#undef RESC
#undef MLOAD
#undef MASK
}
#undef KSWZ
#undef SBAR
}

namespace ret {
using bf16x8 = __attribute__((ext_vector_type(8))) short;
using s16x4  = __attribute__((ext_vector_type(4))) short;
using f32x16 = __attribute__((ext_vector_type(16))) float;
using f32x4v = __attribute__((ext_vector_type(4))) float;
using u32x4  = __attribute__((ext_vector_type(4))) unsigned;
typedef short v4i16_t __attribute__((ext_vector_type(4)));
constexpr int PITCH = 272;
constexpr int IMG = 64 * PITCH;
__device__ __forceinline__ int crow(int r, int hi) { return (r & 3) + 8 * (r >> 2) + 4 * hi; }
__device__ __forceinline__ s16x4 vtr(const LAS char* p) { return __builtin_bit_cast(s16x4, __builtin_amdgcn_ds_read_tr16_b64_v4i16((LAS v4i16_t*)p)); }
__device__ __forceinline__ bf16x8 tr_frag(const LAS char* img, int r_lo, int r_hi, int cb, int lane) {
    const int i = lane & 15; const LAS char* a = img + (i >> 2) * PITCH + (cb + 4 * (i & 3)) * 2;
    const s16x4 lo = vtr(a + r_lo * PITCH), hi = vtr(a + r_hi * PITCH);
    return (bf16x8){lo[0], lo[1], lo[2], lo[3], hi[0], hi[1], hi[2], hi[3]};
}
__device__ __forceinline__ float l2gamma(int h) { return log1pf(-exp2f(-5.0f - (float)h)) * 1.4426950408889634f; }
template <bool SCALE>
__device__ __forceinline__ void stage_chunk(const bf16_t* src, LAS char* img, float l2g, int tid) {
#pragma unroll
    for (int i = 0; i < 2; ++i) {
        const int idx = tid * 2 + i, row = idx >> 4, c16 = idx & 15;
        u32x4 v = *(const u32x4*)(src + (size_t)row * LDP + c16 * 8);
        if (SCALE) {
            const float sd = exp2f((float)(63 - row) * l2g);
#pragma unroll
            for (int q = 0; q < 4; ++q) { const unsigned w = v[q]; v[q] = pk2(__uint_as_float(w << 16) * sd, __uint_as_float(w & 0xffff0000u) * sd); }
        }
        *(LAS u32x4*)(img + row * PITCH + c16 * 16) = v;
    }
}
__device__ __forceinline__ void r1_unit(int bh, int c, const bf16_t* projb, float* kvt, LAS char* lds) {
    const int tid = otid(), lane = tid & 63, wid = tid >> 6, r32 = lane & 31, hh = lane >> 5;
    const int b = bh >> 3, h = bh & 7; const size_t tok0 = (size_t)b * S + 64 * c;
    const float l2g = l2gamma(h);
    LAS char* kimg = lds; LAS char* vimg = lds + IMG;
    stage_chunk<true>(projb + tok0 * LDP + ORK + h * 128, kimg, l2g, tid);
    stage_chunk<false>(projb + tok0 * LDP + ORV + h * 128, vimg, l2g, tid);
    __syncthreads();
    const int eb = wid >> 1, db0 = (wid & 1) * 2, gcol = 16 * ((lane >> 4) & 1);
    f32x16 acc0 = {}, acc1 = {};
#pragma unroll
    for (int ks = 0; ks < 4; ++ks) {
        const int rl = 16 * ks + 8 * hh;
        const bf16x8 a = tr_frag(vimg, rl, rl + 4, 32 * eb + gcol, lane);
        const bf16x8 b0 = tr_frag(kimg, rl, rl + 4, 32 * db0 + gcol, lane);
        const bf16x8 b1 = tr_frag(kimg, rl, rl + 4, 32 * (db0 + 1) + gcol, lane);
        acc0 = __builtin_amdgcn_mfma_f32_32x32x16_bf16(a, b0, acc0, 0, 0, 0);
        acc1 = __builtin_amdgcn_mfma_f32_32x32x16_bf16(a, b1, acc1, 0, 0, 0);
    }
    float* o = kvt + ((size_t)(bh * 32 + c) * 128 + 32 * eb) * 128 + 32 * db0 + r32;
#pragma unroll
    for (int r = 0; r < 16; ++r) { o[(size_t)crow(r, hh) * 128] = acc0[r]; o[(size_t)crow(r, hh) * 128 + 32] = acc1[r]; }
    __syncthreads();
}
__device__ __forceinline__ void r2_scan(const float* kvt, bf16_t* rt, int G) {
    for (int g4 = blockIdx.x * NTHR + otid(); g4 < 32 * 4096; g4 += G * NTHR) {
        const int bh = g4 >> 12, idx = (g4 & 4095) * 4;
        const float cdk = exp2f(64.0f * l2gamma(bh & 7));
        f32x4v R = {0.f, 0.f, 0.f, 0.f};
        const float* kp = kvt + (size_t)bh * 32 * 16384 + idx; bf16_t* rp = rt + (size_t)bh * 32 * 16384 + idx;
#pragma unroll 4
        for (int c = 0; c < 32; ++c) {
            *(unsigned long long*)(rp + (size_t)c * 16384) = (unsigned long long)pk2(R[0], R[1]) | ((unsigned long long)pk2(R[2], R[3]) << 32);
            if (c < 31) { const f32x4v kv = *(const f32x4v*)(kp + (size_t)c * 16384); R = R * cdk + kv; }
        }
    }
}
constexpr int R3_Q = 0, R3_K = IMG, R3_V = 2 * IMG, R3_G = 3 * IMG, R3_R = 4 * IMG, R3_SS = 4 * IMG + 128 * PITCH, R3_LDS = R3_SS + 1024;
struct R3Stage { u32x4 q[2], k[2], v[2], r[4]; };
__device__ __forceinline__ void r3_load(R3Stage& st, int u, const bf16_t* projb, const bf16_t* rt, int tid) {
    const int bh = u >> 5, c = u & 31, b = bh >> 3, h = bh & 7; const size_t tok0 = (size_t)b * S + 64 * c;
#pragma unroll
    for (int i = 0; i < 2; ++i) { const int idx = tid * 2 + i, row = idx >> 4, c16 = idx & 15; const bf16_t* p = projb + (tok0 + row) * LDP + h * 128 + c16 * 8;
        st.q[i] = *(const u32x4*)(p + ORQ); st.k[i] = *(const u32x4*)(p + ORK); st.v[i] = *(const u32x4*)(p + ORV); }
#pragma unroll
    for (int i = 0; i < 4; ++i) { const int idx = tid * 4 + i; st.r[i] = *(const u32x4*)(rt + (size_t)u * 16384 + (size_t)idx * 8); }
}
__device__ __forceinline__ void r3_store_lds(const R3Stage& st, int u, const bf16_t* projb, LAS char* lds, int tid) {
    const int bh_ = u >> 5, c_ = u & 31; const size_t tok0_ = (size_t)(bh_ >> 3) * S + 64 * c_;
#pragma unroll
    for (int i = 0; i < 2; ++i) { const int idx = tid * 2 + i, off = (idx >> 4) * PITCH + (idx & 15) * 16;
        *(LAS u32x4*)(lds + R3_Q + off) = st.q[i]; *(LAS u32x4*)(lds + R3_K + off) = st.k[i]; *(LAS u32x4*)(lds + R3_V + off) = st.v[i];
        *(LAS u32x4*)(lds + R3_G + off) = *(const u32x4*)(projb + (tok0_ + (idx >> 4)) * LDP + ORG + (bh_ & 7) * 128 + (idx & 15) * 8); }
#pragma unroll
    for (int i = 0; i < 4; ++i) { const int idx = tid * 4 + i; *(LAS u32x4*)(lds + R3_R + (idx >> 4) * PITCH + (idx & 15) * 16) = st.r[i]; }
}
__device__ __forceinline__ void r3_compute(int u, const float* rng, bf16_t* catb, LAS char* lds, int tid) {
    const int lane = tid & 63, wid = tid >> 6, r32 = lane & 31, hh = lane >> 5;
    const int bh = u >> 5, c = u & 31, b = bh >> 3, h = bh & 7; const size_t tok0 = (size_t)b * S + 64 * c;
    const float l2g = l2gamma(h);
    LAS float* ssp = (LAS float*)(lds + R3_SS);
    const int nt = wid >> 2, eb = wid & 3, gcol = 16 * ((lane >> 4) & 1);
    bf16x8 qf[8];
    { const LAS char* qp = lds + R3_Q + (32 * nt + r32) * PITCH + 16 * hh;
#pragma unroll
      for (int ks = 0; ks < 8; ++ks) qf[ks] = *(const LAS bf16x8*)(qp + 32 * ks); }
    f32x16 o2 = {};
    { const LAS char* rp = lds + R3_R + (32 * eb + r32) * PITCH + 16 * hh;
#pragma unroll
      for (int ks = 0; ks < 8; ++ks) { const bf16x8 rf = *(const LAS bf16x8*)(rp + 32 * ks); o2 = __builtin_amdgcn_mfma_f32_32x32x16_bf16(qf[ks], rf, o2, 0, 0, 0); } }
    f32x16 o1 = {};
    const int n_lane = 32 * nt + r32;
#pragma unroll
    for (int mt = 0; mt < 2; ++mt) {
        if (mt <= nt) {
            f32x16 X = {};
            const LAS char* kp = lds + R3_K + (32 * mt + r32) * PITCH + 16 * hh;
#pragma unroll
            for (int ks = 0; ks < 8; ++ks) { const bf16x8 kf = *(const LAS bf16x8*)(kp + 32 * ks); X = __builtin_amdgcn_mfma_f32_32x32x16_bf16(kf, qf[ks], X, 0, 0, 0); }
#pragma unroll
            for (int r = 0; r < 16; ++r) { const int m = 32 * mt + crow(r, hh); X[r] = (n_lane >= m) ? X[r] * exp2f((float)(n_lane - m) * l2g) : 0.f; }
#pragma unroll
            for (int sidx = 0; sidx < 2; ++sidx) {
                u32x4 pw;
#pragma unroll
                for (int q = 0; q < 4; ++q) pw[q] = pk2(X[8 * sidx + 2 * q], X[8 * sidx + 2 * q + 1]);
                const int rl = 32 * mt + 16 * sidx + 4 * hh;
                const bf16x8 vf = tr_frag(lds + R3_V, rl, rl + 8, 32 * eb + gcol, lane);
                o1 = __builtin_amdgcn_mfma_f32_32x32x16_bf16(__builtin_bit_cast(bf16x8, pw), vf, o1, 0, 0, 0);
            }
        }
    }
    float o[16];
#pragma unroll
    for (int r = 0; r < 16; ++r) {
        const int n = 32 * nt + crow(r, hh);
        o[r] = o1[r] + o2[r] * exp2f((float)(n + 1) * l2g);
        float sq = o[r] * o[r];
#pragma unroll
        for (int off = 1; off < 32; off <<= 1) sq += __shfl_xor(sq, off);
        if (r32 == 0) ssp[eb * 64 + n] = sq;
    }
    __syncthreads();
    const int e = 32 * eb + r32; const float ge = rng[h * 128 + e];
#pragma unroll
    for (int r = 0; r < 16; ++r) {
        const int n = 32 * nt + crow(r, hh);
        const float tot = (ssp[n] + ssp[64 + n]) + (ssp[128 + n] + ssp[192 + n]);
        const float gt = bf2f(*(const LAS bf16_t*)(lds + R3_G + n * PITCH + e * 2));
        const float y = o[r] * rsqrtf(tot * (1.0f / 128) + EPS) * ge * (gt / (1.0f + __expf(-gt)));
        catb[(tok0 + n) * D + 1024 + h * 128 + e] = (bf16_t)f2bf(y);
    }
}
__device__ __forceinline__ void r3_phase(const bf16_t* projb, const bf16_t* rt, const float* rng, bf16_t* catb, LAS char* lds, int G) {
    const int tid = otid();
    int u = blockIdx.x;
    if (u >= 1024) return;
    R3Stage st; r3_load(st, u, projb, rt, tid);
    for (; u < 1024; u += G) {
        r3_store_lds(st, u, projb, lds, tid);
        __syncthreads();
        if (u + G < 1024) r3_load(st, u + G, projb, rt, tid);
        r3_compute(u, rng, catb, lds, tid);
        __syncthreads();
    }
}
}

typedef float f32x4g __attribute__((ext_vector_type(4)));
__device__ __forceinline__ void unpack8(const v4u v, float (&f)[8]) {
#pragma unroll
    for (int q = 0; q < 4; ++q) { f[2 * q] = __uint_as_float(v[q] << 16); f[2 * q + 1] = __uint_as_float(v[q] & 0xffff0000u); }
}
__device__ __forceinline__ v4u pack8(const float (&f)[8]) { v4u o; o.x = pk2(f[0], f[1]); o.y = pk2(f[2], f[3]); o.z = pk2(f[4], f[5]); o.w = pk2(f[6], f[7]); return o; }
__device__ __forceinline__ void pp_token(int t, int lane, bf16_t* pb, float* iwf, bf16_t* ikc, const float* qg, const float* kg, const float* lnw, const float* lnb, const float2* rot) {
    bf16_t* p = pb + (size_t)t * LDP;
    const int tl = t & (S - 1);
    v4u qk[3];
#pragma unroll
    for (int i = 0; i < 3; ++i) { const int chunk = 64 * i + lane; qk[i] = (chunk < 160) ? *(const v4u*)(p + chunk * 8) : (v4u){0u, 0u, 0u, 0u}; }
    const bool ika = lane < 8; const int ikcn = ika ? lane : 0;
    const v4u ikv = *(const v4u*)(p + OIK + ikcn * 8);
    const bf16_t iwv = p[OIW + (lane & 15)];
    v4u r1[2], r2[2]; f32x4g cs[2][4];
#pragma unroll
    for (int i = 0; i < 2; ++i) { const int task = 64 * i + lane, inst = task >> 3, c = task & 7; const bf16_t* r = p + ORQ + inst * 128 + c * 8;
        r1[i] = *(const v4u*)r; r2[i] = *(const v4u*)(r + 64);
        const f32x4g* cp = (const f32x4g*)(rot + tl * 64 + c * 8);
#pragma unroll
        for (int q = 0; q < 4; ++q) cs[i][q] = cp[q]; }
    asm volatile("" ::: "memory");
#pragma unroll
    for (int i = 0; i < 3; ++i) {
        const int chunk = 64 * i + lane;
        float f[8]; unpack8(qk[i], f);
        float ss = 0.f;
#pragma unroll
        for (int j = 0; j < 8; ++j) ss += f[j] * f[j];
        ss += __shfl_xor(ss, 1); ss += __shfl_xor(ss, 2); ss += __shfl_xor(ss, 4); ss += __shfl_xor(ss, 8);
        const float r = rsqrtf(ss * (1.0f / 128) + EPS);
        if (chunk < 160) {
            const float* g = ((chunk >> 4) < 8 ? qg : kg) + (chunk & 15) * 8;
            const f32x4g g0 = *(const f32x4g*)g, g1 = *(const f32x4g*)(g + 4);
            f[0] *= r * g0[0]; f[1] *= r * g0[1]; f[2] *= r * g0[2]; f[3] *= r * g0[3]; f[4] *= r * g1[0]; f[5] *= r * g1[1]; f[6] *= r * g1[2]; f[7] *= r * g1[3];
            *(v4u*)(p + chunk * 8) = pack8(f);
        }
    }
    {
        float f[8]; unpack8(ikv, f);
        float sm_ = 0.f;
#pragma unroll
        for (int j = 0; j < 8; ++j) sm_ += f[j];
        sm_ += __shfl_xor(sm_, 1); sm_ += __shfl_xor(sm_, 2); sm_ += __shfl_xor(sm_, 4);
        const float mean = sm_ * (1.0f / 64);
        float vs = 0.f;
#pragma unroll
        for (int j = 0; j < 8; ++j) { f[j] -= mean; vs += f[j] * f[j]; }
        vs += __shfl_xor(vs, 1); vs += __shfl_xor(vs, 2); vs += __shfl_xor(vs, 4);
        const float r = rsqrtf(vs * (1.0f / 64) + EPS);
#pragma unroll
        for (int j = 0; j < 8; ++j) f[j] = f[j] * r * lnw[ikcn * 8 + j] + lnb[ikcn * 8 + j];
        if (ika) { const v4u o = pack8(f); *(v4u*)(p + OIK + ikcn * 8) = o; *(v4u*)(ikc + (size_t)t * 64 + ikcn * 8) = o; }
    }
    if (lane < 16) iwf[(size_t)t * 16 + lane] = bf2f(iwv) * 0.03125f;
#pragma unroll
    for (int i = 0; i < 2; ++i) {
        const int task = 64 * i + lane, inst = task >> 3, c = task & 7;
        bf16_t* r = p + ORQ + inst * 128 + c * 8;
        float x1[8], x2[8]; unpack8(r1[i], x1); unpack8(r2[i], x2);
        const float sc = (inst >= 8) ? 0.08838834764831845f : 1.f;
        float y1[8], y2[8];
#pragma unroll
        for (int j = 0; j < 8; ++j) { const float co = cs[i][j >> 1][(j & 1) * 2], si = cs[i][j >> 1][(j & 1) * 2 + 1]; y1[j] = (x1[j] * co - x2[j] * si) * sc; y2[j] = (x1[j] * si + x2[j] * co) * sc; }
        *(v4u*)r = pack8(y1); *(v4u*)(r + 64) = pack8(y2);
    }
}

constexpr int TPW = 2;
__device__ __forceinline__ float dot4(const f32x4g a, const f32x4g w) { return (a[0] * w[0] + a[1] * w[1]) + (a[2] * w[2] + a[3] * w[3]); }
__device__ __forceinline__ void router_chunk_load(f32x4g (&pf)[4], const float* wrt, int e, int T_) {
#pragma unroll
    for (int g = 0; g < 4; ++g) pf[g] = *(const f32x4g*)(wrt + (size_t)(4 + g * 8 + e) * D + 4 * T_);
}
__device__ __forceinline__ void router_chunk_write(const f32x4g (&pf)[4], LAS float* buf, int T_) {
#pragma unroll
    for (int g = 0; g < 4; ++g) *(LAS f32x4g*)(buf + g * 2048 + 4 * T_) = pf[g];
}
__device__ __forceinline__ void router_pass(int t0, int T_, int lane, LAS float* lsm, const float* x1, const float* g2, const float* wrt, bf16_t* xn2, int* eid, float* ew, int* cnt) {
    LAS float* wgT = lsm;
    f32x4g pf[4];
    router_chunk_load(pf, wrt, 0, T_);
    f32x4g h[TPW][8];
#pragma unroll
    for (int k = 0; k < TPW; ++k) {
        const f32x4g* xa = (const f32x4g*)(x1 + (size_t)(t0 + k) * D) + lane;
#pragma unroll
        for (int j = 0; j < 8; ++j) h[k][j] = xa[64 * j];
    }
#pragma unroll
    for (int k = 0; k < TPW; ++k) {
        float sa = 0.f;
#pragma unroll
        for (int j = 0; j < 8; ++j) sa += dot4(h[k][j], h[k][j]);
        const float ra = rsqrtf(wave_sum(sa) * (1.0f / D) + EPS);
        unsigned long long* oa = (unsigned long long*)(xn2 + (size_t)(t0 + k) * D) + lane; const f32x4g* gp = (const f32x4g*)g2 + lane;
#pragma unroll
        for (int j = 0; j < 8; ++j) { h[k][j] = h[k][j] * ra * gp[64 * j];
            oa[64 * j] = (unsigned long long)pk2(h[k][j][0], h[k][j][1]) | ((unsigned long long)pk2(h[k][j][2], h[k][j][3]) << 32); }
        __builtin_amdgcn_sched_barrier(0);
    }
    __syncthreads();
    router_chunk_write(pf, lsm + 8192, T_);
    int gs[TPW]; float gate[TPW];
#pragma unroll
    for (int k = 0; k < TPW; ++k) {
        float gl[4];
#pragma unroll
        for (int c = 0; c < 4; ++c) { float a = 0.f;
#pragma unroll
            for (int j = 0; j < 8; ++j) a += dot4(h[k][j], *(const LAS f32x4g*)(wgT + c * 2048 + 256 * j + 4 * lane));
            gl[c] = wave_sum(a); __builtin_amdgcn_sched_barrier(0); }
        int g = 0; float gm = gl[0];
#pragma unroll
        for (int c = 1; c < 4; ++c) if (gl[c] > gm) { gm = gl[c]; g = c; }
        float den = 0.f;
#pragma unroll
        for (int c = 0; c < 4; ++c) den += expf(gl[c] - gm);
        gs[k] = g; gate[k] = 1.0f / den;
    }
    float m0[TPW], m1[TPW]; int i0[TPW], i1[TPW];
#pragma unroll
    for (int k = 0; k < TPW; ++k) { m0[k] = -INFINITY; m1[k] = -INFINITY; i0[k] = 0; i1[k] = 0; }
#pragma unroll 1
    for (int e = 0; e < 8; ++e) {
        __syncthreads();
        if (e < 7) router_chunk_load(pf, wrt, e + 1, T_);
        const LAS float* buf = lsm + 8192 + (e & 1) * 8192;
#pragma unroll
        for (int k = 0; k < TPW; ++k) {
            const LAS float* wp = buf + gs[k] * 2048 + 4 * lane; float a = 0.f;
#pragma unroll
            for (int j = 0; j < 8; ++j) a += dot4(h[k][j], *(const LAS f32x4g*)(wp + 256 * j));
            a = wave_sum(a);
            if (a > m0[k]) { m1[k] = m0[k]; i1[k] = i0[k]; m0[k] = a; i0[k] = e; } else if (a > m1[k]) { m1[k] = a; i1[k] = e; }
            __builtin_amdgcn_sched_barrier(0);
        }
        if (e < 7) router_chunk_write(pf, lsm + 8192 + ((e + 1) & 1) * 8192, T_);
    }
    {
        int g = gs[0], a0 = i0[0], a1 = i1[0]; float gt = gate[0], v0 = m0[0], v1 = m1[0];
#pragma unroll
        for (int k = 1; k < TPW; ++k) if (lane == k) { g = gs[k]; gt = gate[k]; a0 = i0[k]; a1 = i1[k]; v0 = m0[k]; v1 = m1[k]; }
        const float e1 = expf(v1 - v0); const float w0 = 1.0f / (1.0f + e1) * gt, w1 = e1 / (1.0f + e1) * gt;
        if (lane < TPW) { const int t = t0 + lane;
            eid[t * 2] = g * 8 + a0; eid[t * 2 + 1] = g * 8 + a1; ew[t * 2] = w0; ew[t * 2 + 1] = w1;
            atomicAdd(&cnt[(g * 8 + a0) * 64], 1); atomicAdd(&cnt[(g * 8 + a1) * 64], 1); }
    }
}

__device__ __forceinline__ void fill_token(int t, int lane, const int* soff, const int* eid, const float* ew, int* fill, int* slot_of, float* slotw, int* rowmap) {
    if (lane < 2) { const int e = eid[t * 2 + lane]; const int slot = soff[e] + atomicAdd(&fill[e * 64], 1); slot_of[t * 2 + lane] = slot; slotw[slot] = ew[t * 2 + lane]; rowmap[slot] = t; }
}
__device__ __forceinline__ void combine_token(int t, int lane, float* out, const bf16_t* y, const int* slot_of) {
    const int s0 = slot_of[t * 2], s1 = slot_of[t * 2 + 1];
    const v4u* y0 = (const v4u*)(y + (size_t)s0 * D) + lane; const v4u* y1 = (const v4u*)(y + (size_t)s1 * D) + lane;
    f32x4g* o = (f32x4g*)(out + (size_t)t * D) + 2 * lane;
#pragma unroll
    for (int j = 0; j < 4; ++j) {
        float a[8], b[8]; unpack8(y0[64 * j], a); unpack8(y1[64 * j], b);
        f32x4g o0 = o[128 * j], o1 = o[128 * j + 1];
        o0[0] += a[0] + b[0]; o0[1] += a[1] + b[1]; o0[2] += a[2] + b[2]; o0[3] += a[3] + b[3];
        o1[0] += a[4] + b[4]; o1[1] += a[5] + b[5]; o1[2] += a[6] + b[6]; o1[3] += a[7] + b[7];
        o[128 * j] = o0; o[128 * j + 1] = o1;
    }
}

#define XB_TMO      128
#define XB_XCNT(j)  (256  + 64 * (j))
#define XB_XSUB(j)  (1280 + 64 * (j))
#define XB_XGEN(j)  (2304 + 64 * (j))
#define XB_TOP      3328
#define XB_TOPGEN   3392
#define XCD_BAR_WORDS 3456
#define XB_SPIN_CAP (1u << 18)

__device__ __forceinline__ unsigned xb_ld(unsigned* p)              { return __hip_atomic_load(p, __ATOMIC_RELAXED, __HIP_MEMORY_SCOPE_AGENT); }
__device__ __forceinline__ unsigned xb_add(unsigned* p, unsigned v) { return __hip_atomic_fetch_add(p, v, __ATOMIC_RELAXED, __HIP_MEMORY_SCOPE_AGENT); }
__device__ __forceinline__ unsigned xb_xcc_id() { return (unsigned)__builtin_amdgcn_s_getreg((3 << 11) | 20) & 0xFu; }
#define XB_SPIN(cond, bar) do { unsigned _sp = 0; while (cond) { __builtin_amdgcn_s_sleep(1); \
    if ((++_sp & 255u) == 0u) { if (xb_ld(&(bar)[XB_TMO])) break; if (_sp > XB_SPIN_CAP) { atomicAdd(&(bar)[XB_TMO], 1u); break; } } } } while (0)

struct XcdBarrier {
    unsigned* bar; unsigned x;
    volatile LAS unsigned* st;
};

__device__ __forceinline__ XcdBarrier xcd_barrier_post(unsigned* bar, volatile LAS unsigned* st) {
    XcdBarrier b; b.bar = bar; b.x = xb_xcc_id(); b.st = st;
    if (threadIdx.x == 0) (void)xb_add(&bar[XB_XCNT(b.x)], 1u);
    return b;
}
__device__ __forceinline__ void xcd_barrier_complete(unsigned* bar, unsigned x, unsigned& nloc, unsigned& nx) {
    const unsigned G = gridDim.x * gridDim.y * gridDim.z;
    unsigned sum, cnt, mine, sp = 0u;
    for (;;) {
        sum = 0u; cnt = 0u; mine = 0u;
#pragma unroll
        for (unsigned j = 0; j < 16; ++j) { const unsigned c = xb_ld(&bar[XB_XCNT(j)]); sum += c; cnt += (c > 0u) ? 1u : 0u; mine = (j == x) ? c : mine; }
        if (sum == G) break;
        __builtin_amdgcn_s_sleep(1);
        if ((++sp & 255u) == 0u) { if (xb_ld(&bar[XB_TMO])) break; if (sp > XB_SPIN_CAP) { atomicAdd(&bar[XB_TMO], 1u); break; } }
    }
    nloc = mine > 0u ? mine : 1u; nx = cnt > 0u ? cnt : 1u;
}

__device__ __forceinline__ void xcd_barrier(const XcdBarrier& b) {
    asm volatile("s_waitcnt vmcnt(0)" ::: "memory");
    __syncthreads();
    if (threadIdx.x == 0) {
        unsigned* bar = b.bar;
        __builtin_amdgcn_s_waitcnt(0);
        unsigned nloc = b.st[0], nx = b.st[1];
        if (nloc == 0u) { xcd_barrier_complete(bar, b.x, nloc, nx); b.st[0] = nloc; b.st[1] = nx; }
        const unsigned old = xb_add(&bar[XB_XSUB(b.x)], 1u);
        const unsigned gen = old / nloc;
        if (old + 1u == (gen + 1u) * nloc) {
            __builtin_amdgcn_fence(__ATOMIC_RELEASE, "agent");
            asm volatile("s_waitcnt vmcnt(0)" ::: "memory");
            const unsigned og = xb_add(&bar[XB_TOP], 1u);
            const unsigned tg = og / nx;
            if (og + 1u == (tg + 1u) * nx) xb_add(&bar[XB_TOPGEN], 1u);
            else XB_SPIN(xb_ld(&bar[XB_TOPGEN]) == tg, bar);
            __builtin_amdgcn_fence(__ATOMIC_ACQUIRE, "agent");
            xb_add(&bar[XB_XGEN(b.x)], 1u);
            asm volatile("s_waitcnt vmcnt(0)" ::: "memory");
        } else {
            XB_SPIN(xb_ld(&bar[XB_XGEN(b.x)]) == gen, bar);
            __builtin_amdgcn_fence(__ATOMIC_ACQUIRE, "agent");
            asm volatile("s_waitcnt vmcnt(0)" ::: "memory");
        }
    }
    __syncthreads();
}

__global__ void __launch_bounds__(NTHR, 2) mega(Params P) {
    extern __shared__ __attribute__((aligned(16))) unsigned char lds[];
    int* soff = (int*)(lds + 2 * SUB_LDS);
    volatile LAS unsigned* bst = (volatile LAS unsigned*)((LAS unsigned char*)lds + 2 * SUB_LDS + 256);
    if (threadIdx.x < 4) bst[threadIdx.x] = 0u;
    __syncthreads();
    const XcdBarrier xbar = xcd_barrier_post((unsigned*)(P.ws + WS_BAR), bst);
    const int G = gridDim.x, nsb = G * 2, NGW = G * NWAVES;
#define PHASE_IDS() const int T_ = otid(); const int sub = T_ >> 8, tid = T_ & 255, lane = T_ & 63, wave = __builtin_amdgcn_readfirstlane(T_ >> 6); \
    float* sm = (float*)(lds + sub * SUB_LDS); const int sb = blockIdx.x * 2 + sub, gw = blockIdx.x * NWAVES + wave; (void)tid; (void)lane; (void)sm; (void)sb; (void)gw;
    char* ws = P.ws;
    int* cnt = (int*)(ws + WS_CTL); int* fill = cnt + 2048; int* off = cnt + 7680; int* tile_e = cnt + 7744;
    int* eid = (int*)(ws + WS_EID); float* ew = (float*)(ws + WS_EW); int* slot_of = (int*)(ws + WS_SLOT); float* slotw = (float*)(ws + WS_SLOTW);
    float2* rot = (float2*)(ws + WS_ROT);
    bf16_t* projb = (bf16_t*)(ws + WS_PROJB); unsigned long long* maskw = (unsigned long long*)(ws + WS_MASK); bf16_t* ikc = (bf16_t*)(ws + WS_IKC); bf16_t* catb = (bf16_t*)(ws + WS_CATB);
    bf16_t* yb = (bf16_t*)(ws + WS_PROJB); int* rowmap = (int*)(ws + WS_ROWMAP); bf16_t* hhb = (bf16_t*)(ws + WS_CATB);
    bf16_t* wint = (bf16_t*)(ws + WS_WINT); bf16_t* woutt = (bf16_t*)(ws + WS_WOUTT); bf16_t* w13t = (bf16_t*)(ws + WS_W13T); bf16_t* w2t = (bf16_t*)(ws + WS_W2T);
    bf16_t* xn = (bf16_t*)(ws + WS_XN); bf16_t* xn2 = xn; float* kvt = (float*)(ws + WS_KVT); bf16_t* rtb = (bf16_t*)(ws + WS_RT); float* iwf = (float*)(ws + WS_IWF); float* wrt = (float*)(ws + WS_WRT);

    { PHASE_IDS();
    for (int idx = blockIdx.x * NTHR + T_; idx < 2048 * 64; idx += G * NTHR) {
        const int pos = idx >> 6, i = idx & 63;
        const double inv = exp(-log(10000.0) * (double)i / 63.0);
        const double ang = (double)pos * inv;
        rot[idx] = make_float2((float)cos(ang), (float)sin(ang));
    }
    for (int idx = blockIdx.x * NTHR + T_; idx < 36 * 2048; idx += G * NTHR) {
        const int c = idx >> 11, d = idx & 2047;
        wrt[idx] = (c < 4) ? P.w_group[(size_t)d * 4 + c] : P.w_router[((size_t)((c - 4) >> 3) * D + d) * 8 + ((c - 4) & 7)];
    }
    {
        LAS float* scr = (LAS float*)((LAS unsigned char*)lds + wave * 16384);
        constexpr int I_IN = (D / 64) * (LDP / 32), I_OUT = (D / 64) * (D / 32), I_13 = NE * (D / 64) * (FF / 32), I_2 = NE * (FF / 64) * (D / 32);
        constexpr int NITEMS = I_IN + I_OUT + 2 * I_13 + I_2;
        for (int it = gw; it < NITEMS; it += NGW) {
            int r = it;
            if (r < I_IN) { const int nb = r % (LDP / 32), kb = r / (LDP / 32); p0_transpose_item(P.w_in, D, INW, 64 * kb, 32 * nb, wint, 32 * nb, scr, lane); continue; } r -= I_IN;
            if (r < I_OUT) { const int nb = r % (D / 32), kb = r / (D / 32); p0_transpose_item(P.w_out, D, D, 64 * kb, 32 * nb, woutt, 32 * nb, scr, lane); continue; } r -= I_OUT;
            if (r < 2 * I_13) {
                const int which = r / I_13; r -= which * I_13;
                const int e = r / ((D / 64) * (FF / 32)); r -= e * ((D / 64) * (FF / 32));
                const int nb = r % (FF / 32), kb = r / (FF / 32), n0 = 32 * nb;
                const float* W = (which ? P.w3 : P.w1) + (size_t)e * D * FF;
                p0_transpose_item(W, D, FF, 64 * kb, n0, w13t + (size_t)e * 1024 * D, (n0 >> 7) * 256 + which * 128 + (n0 & 127), scr, lane); continue; }
            r -= 2 * I_13;
            { const int e = r / ((FF / 64) * (D / 32)); r -= e * ((FF / 64) * (D / 32));
              const int nb = r % (D / 32), kb = r / (D / 32);
              p0_transpose_item(P.w2 + (size_t)e * FF * D, FF, D, 64 * kb, 32 * nb, w2t + (size_t)e * D * FF, 32 * nb, scr, lane); }
        }
        for (int m = gw; m < NT; m += NGW) rms_row_to_bf16(P.x + (size_t)m * D, P.norm1_g, xn + (size_t)m * D, lane);
    }
    }
    xcd_barrier(xbar);
    {
        pg8::Gemm g{xn, wint, NT, LDP, D}; pg8::StaticOrder SO; SO.init(NT, LDP, G, (int)blockIdx.x);
        pg8::EpiBf16 E{projb, LDP};
        pg8::gemm_phase<pg8::EpiBf16, pg8::StaticOrder, true, true>((LAS unsigned char*)lds, g, SO, E);
    }
    xcd_barrier(xbar);
    { PHASE_IDS(); for (int t = gw; t < NT; t += NGW) pp_token(t, lane, projb, iwf, ikc, P.q_norm_g, P.k_norm_g, P.ln_w, P.ln_b, rot); }
    xcd_barrier(xbar);
    { PHASE_IDS();
    for (int i = 0; i * G + (int)blockIdx.x < NT / 16; ++i) {
        const int L = i * G + (int)blockIdx.x;
        const int u = (L < 256) ? L : 256 + (L & 128) + (127 - (L & 127));
        idx_unit(u, T_, projb, ikc, iwf, maskw, (LAS char*)lds);
    }
    }
    __syncthreads();
    for (int u = blockIdx.x; u < 1024; u += G) { if ((u & 31) != 31) ret::r1_unit(u >> 5, u & 31, projb, kvt, (LAS char*)lds); }
    xcd_barrier(xbar);
    for (int u = blockIdx.x; u < 256; u += G) {
        const int bg = u & 7, pp = u >> 3, bb = bg >> 1, g = bg & 1;
        const int wv = __builtin_amdgcn_readfirstlane(otid() >> 6), h = g * 4 + (wv & 3), qblk = (wv < 4) ? pp : 63 - pp;
        const size_t row0 = (size_t)bb * S, qrow = row0 + 32 * qblk;
        att::att_unit<LDP, LDP, D, S>(projb + qrow * LDP + OQ + h * 128, projb + row0 * LDP + OKK + g * 128, projb + row0 * LDP + OV + g * 128,
                                      catb + qrow * D + h * 128, maskw + (size_t)(bb * 32) * S + 32 * qblk, qblk / 2 + 1, (63 - pp) / 2 + 1, (char*)lds);
    }
    ret::r2_scan(kvt, rtb, G);
    xcd_barrier(xbar);
    ret::r3_phase(projb, rtb, P.ret_g, catb, (LAS char*)lds, G);
    xcd_barrier(xbar);
    {
        pg8::Gemm g{catb, woutt, NT, D, D}; pg8::StaticOrder SO; SO.init(NT, D, G, (int)blockIdx.x);
        pg8::EpiF32Res E{P.x, P.out, D};
        pg8::gemm_phase<pg8::EpiF32Res, pg8::StaticOrder, true, true>((LAS unsigned char*)lds, g, SO, E);
    }
    xcd_barrier(xbar);
    { PHASE_IDS();
      LAS float* lsm = (LAS float*)(LAS unsigned char*)lds;
      for (int i = T_; i < 2048; i += NTHR) *(LAS f32x4g*)(lsm + 4 * i) = *(const f32x4g*)(wrt + 4 * i);
      for (int pass = blockIdx.x; pass < NT / (8 * TPW); pass += G) router_pass(pass * 8 * TPW + wave * TPW, T_, lane, lsm, P.out, P.norm2_g, wrt, xn2, eid, ew, cnt);
    }
    xcd_barrier(xbar);
    { PHASE_IDS();
    if (T_ == 0) {
        int o = 0;
        for (int e = 0; e < NE; ++e) {
            soff[e] = o; const int nt = (cnt[e * 64] + 255) / 256;
            if (blockIdx.x == 0) { off[e] = o; for (int i = 0; i < nt; ++i) tile_e[o / 256 + i] = e; }
            o += nt * 256;
        }
        soff[NE] = o;
        if (blockIdx.x == 0) { off[NE] = o; for (int i = o / 256; i < MAXTILES; ++i) tile_e[i] = 0; }
    }
    __syncthreads();
    for (int t = gw; t < NT; t += NGW) fill_token(t, lane, soff, eid, ew, fill, slot_of, slotw, rowmap);
    for (int e = blockIdx.x; e < NE; e += G) {
        const int r0 = soff[e] + cnt[e * 64], r1 = soff[e + 1];
        for (int r = r0 + T_; r < r1; r += NTHR) { slotw[r] = 0.f; rowmap[r] = 0; }
    }
    }
    xcd_barrier(xbar);
    const int mtiles = off[NE] / 256;
    {
        pg8::Gemm g{xn2, w13t, MAXROWS, 1024, D}; pg8::GroupedOrder SO{tile_e, mtiles, 4, G, (int)blockIdx.x, (size_t)1024 * D, rowmap};
        pg8::EpiSwiglu E{hhb, FF, slotw};
        pg8::gemm_phase<pg8::EpiSwiglu, pg8::GroupedOrder, true, true>((LAS unsigned char*)lds, g, SO, E);
    }
    xcd_barrier(xbar);
    {
        pg8::Gemm g{hhb, w2t, MAXROWS, D, FF}; pg8::GroupedOrder SO{tile_e, mtiles, 8, G, (int)blockIdx.x, (size_t)D * FF, nullptr};
        pg8::EpiBf16 E{yb, D};
        pg8::gemm_phase<pg8::EpiBf16, pg8::GroupedOrder, true, true>((LAS unsigned char*)lds, g, SO, E);
    }
    xcd_barrier(xbar);
    { PHASE_IDS();
    for (int t = gw; t < NT; t += NGW) combine_token(t, lane, P.out, yb, slot_of);
    }
}

extern "C" void kernel_launch(void* const* d_in, const int* in_sizes, int n_in, void* d_out, int out_size, void* d_ws, size_t ws_size, hipStream_t stream) {
    static int grid_blocks = 0;
    if (grid_blocks == 0) {
        if (n_in != 15 || in_sizes[0] != NT * D || out_size != NT * D || ws_size < WS_END) {
            fprintf(stderr, "kernel_launch: unexpected shapes n_in %d in0 %d out %d ws %zu\n", n_in, n_in > 0 ? in_sizes[0] : -1, out_size, ws_size);
            grid_blocks = -1; return;
        }
        int dev = 0, cus = 0, per_cu = 0;
        (void)hipGetDevice(&dev);
        (void)hipDeviceGetAttribute(&cus, hipDeviceAttributeMultiprocessorCount, dev);
        (void)hipFuncSetAttribute((const void*)mega, hipFuncAttributeMaxDynamicSharedMemorySize, LDS_BYTES);
        (void)hipOccupancyMaxActiveBlocksPerMultiprocessor(&per_cu, (const void*)mega, NTHR, LDS_BYTES);
        if (per_cu < 1) { fprintf(stderr, "kernel_launch: occupancy query says %d blocks/CU\n", per_cu); per_cu = 1; }
        if (per_cu > 1) per_cu = 1;
        grid_blocks = 1; while (grid_blocks * 2 <= cus * per_cu) grid_blocks *= 2;
        fprintf(stderr, "kernel_launch: grid %d (cus %d)\n", grid_blocks, cus);
    }
    if (grid_blocks < 0) return;
    (void)hipMemsetAsync((char*)d_ws + WS_CTL, 0, 32768, stream);
    Params p{};
    p.x = (const float*)d_in[0]; p.norm1_g = (const float*)d_in[1]; p.w_in = (const float*)d_in[2]; p.q_norm_g = (const float*)d_in[3];
    p.k_norm_g = (const float*)d_in[4]; p.ln_w = (const float*)d_in[5]; p.ln_b = (const float*)d_in[6]; p.ret_g = (const float*)d_in[7];
    p.w_out = (const float*)d_in[8]; p.norm2_g = (const float*)d_in[9]; p.w_group = (const float*)d_in[10]; p.w_router = (const float*)d_in[11];
    p.w1 = (const float*)d_in[12]; p.w3 = (const float*)d_in[13]; p.w2 = (const float*)d_in[14];
    p.out = (float*)d_out; p.ws = (char*)d_ws;
    void* args[] = {&p};
    hipError_t e = hipLaunchCooperativeKernel((const void*)mega, dim3(grid_blocks), dim3(NTHR), args, LDS_BYTES, stream);
    if (e != hipSuccess) fprintf(stderr, "cooperative launch failed: %s (grid %d)\n", hipGetErrorString(e), grid_blocks);
}
```
